# Optimizing an MI355X kernel written in HIP

```python
import jax, jax.numpy as jnp
from jax import lax
import numpy as np

D_MODEL = 1024
BATCH = 8
SEQ = 8192
DEPTH = 1
DEC_BATCH = 8
DEC_SEQ = 16
PAST_LEN = 4096

CHUNK = 64
Q_BLOCK = 128
EPS = 1e-6
D_FF = 2816
MLA_HEADS = 8
Q_LORA = 384
KV_LORA = 256
NOPE_DIM = 64
ROPE_DIM = 32
MLA_V_DIM = 64
ROPE_THETA = 10000.0
FOX_HEADS = 8
FOX_HEAD_DIM = 64
FOX_W = FOX_HEADS * FOX_HEAD_DIM
MIX_W = MLA_HEADS * MLA_V_DIM + FOX_W
IN_COLS = Q_LORA + KV_LORA + ROPE_DIM + 3 * FOX_W + FOX_HEADS

kernel_name = "mla_fox_macaron_streaming_step"


def _rmsnorm(x, g):
    x32 = x.astype(jnp.float32)
    y = x32 * lax.rsqrt(jnp.mean(x32 * x32, axis=-1, keepdims=True) + EPS)
    return (y * g.astype(jnp.float32)).astype(x.dtype)


def _swiglu(x, w_gu, w_down):
    gate, up = jnp.split(x @ w_gu, 2, axis=-1)
    return (jax.nn.silu(gate) * up) @ w_down


def _rope(x, pos):
    half = x.shape[-1] // 2
    freqs = ROPE_THETA ** (-jnp.arange(half, dtype=jnp.float32) / half)
    ang = pos.astype(jnp.float32)[:, None] * freqs[None, :]
    cos = jnp.cos(ang)[None, :, None, :]
    sin = jnp.sin(ang)[None, :, None, :]
    x1 = x[..., :half].astype(jnp.float32)
    x2 = x[..., half:].astype(jnp.float32)
    out = jnp.concatenate([x1 * cos - x2 * sin, x1 * sin + x2 * cos], axis=-1)
    return out.astype(x.dtype)


def _attend(q, k, v, q_pos, k_pos, per_frame, lq=None, lk=None):
    B, Tq, H, dk = q.shape
    qb = Q_BLOCK if Tq % Q_BLOCK == 0 else Tq
    nb = Tq // qb
    scale = dk ** -0.5
    k_chunk = k_pos // CHUNK
    decay = lq is not None
    lk_t = jnp.swapaxes(lk, 1, 2)[:, :, None, :] if decay else None

    def block(xs):
        qi, pi = xs[0], xs[1]
        s = jnp.einsum('bqhd,bkhd->bhqk', qi, k, preferred_element_type=jnp.float32) * scale
        if per_frame:
            mask = k_pos[None, :] <= pi[:, None]
        else:
            mask = k_chunk[None, :] <= (pi // CHUNK)[:, None]
        if decay:
            li = jnp.swapaxes(xs[2], 1, 2)[..., None]
            s = s + (li - lk_t)
        s = jnp.where(mask[None, None], s, -jnp.inf)
        p = jax.nn.softmax(s, axis=-1)
        return jnp.einsum('bhqk,bkhd->bqhd', p.astype(v.dtype), v)

    xs = (jnp.swapaxes(q.reshape(B, nb, qb, H, dk), 0, 1), q_pos.reshape(nb, qb))
    if decay:
        xs = xs + (jnp.swapaxes(lq.reshape(B, nb, qb, H), 0, 1),)
    o = lax.map(block, xs)
    return jnp.swapaxes(o, 0, 1).reshape(B, Tq, H, v.shape[-1])


def _token_mix(u, q_pos, past, w_in, b_forget, g_q_latent, w_q_up, g_kv_latent, w_kv_up, w_out):
    B, T, _ = u.shape
    proj = u @ w_in
    sizes = (Q_LORA, KV_LORA, ROPE_DIM, FOX_W, FOX_W, FOX_W, FOX_HEADS)
    idx = np.cumsum(sizes)[:-1].tolist()
    c_q, c_kv, k_rope, f_q, f_k, f_v, f_gate = jnp.split(proj, idx, axis=-1)

    q = (_rmsnorm(c_q, g_q_latent) @ w_q_up).reshape(B, T, MLA_HEADS, NOPE_DIM + ROPE_DIM)
    q = jnp.concatenate([q[..., :NOPE_DIM], _rope(q[..., NOPE_DIM:], q_pos)], axis=-1)
    c_kv = _rmsnorm(c_kv, g_kv_latent)
    k_rope = _rope(k_rope[:, :, None, :], q_pos)[:, :, 0, :]

    f_q = f_q.reshape(B, T, FOX_HEADS, FOX_HEAD_DIM)
    f_k = f_k.reshape(B, T, FOX_HEADS, FOX_HEAD_DIM)
    f_v = f_v.reshape(B, T, FOX_HEADS, FOX_HEAD_DIM)
    logf = jax.nn.log_sigmoid(f_gate.astype(jnp.float32) + b_forget.astype(jnp.float32))

    new_rows = (c_kv, k_rope, f_k, f_v, logf)
    if past is None:
        ckv_all, krope_all, fk_all, fv_all, logf_all = new_rows
        k_pos = q_pos
    else:
        p_ckv, p_krope, p_fk, p_fv, p_logf = past
        ckv_all = jnp.concatenate([p_ckv, c_kv], axis=1)
        krope_all = jnp.concatenate([p_krope, k_rope], axis=1)
        fk_all = jnp.concatenate([p_fk, f_k], axis=1)
        fv_all = jnp.concatenate([p_fv, f_v], axis=1)
        logf_all = jnp.concatenate([p_logf.astype(jnp.float32), logf], axis=1)
        k_pos = jnp.arange(ckv_all.shape[1])
    Tk = ckv_all.shape[1]

    kv = (ckv_all @ w_kv_up).reshape(B, Tk, MLA_HEADS, NOPE_DIM + MLA_V_DIM)
    k_mla = jnp.concatenate(
        [kv[..., :NOPE_DIM], jnp.broadcast_to(krope_all[:, :, None, :], (B, Tk, MLA_HEADS, ROPE_DIM))], axis=-1)
    o_mla = _attend(q, k_mla, kv[..., NOPE_DIM:], q_pos, k_pos, per_frame=False)

    lk = jnp.cumsum(logf_all, axis=1)
    lq = lk[:, Tk - T:]
    o_fox = _attend(f_q, fk_all, fv_all, q_pos, k_pos, True, lq, lk)

    o = jnp.concatenate([o_mla.reshape(B, T, -1), o_fox.reshape(B, T, -1)], axis=-1) @ w_out
    return o, new_rows


def setup_inputs(seed: int = 0) -> dict:
    key = jax.random.key(seed)
    ks = jax.random.split(key, 32)
    f32 = jnp.float32

    def nrm(k, shape, scale=1.0):
        return jax.random.normal(k, shape, f32) * scale

    def gain(k, n):
        return 1.0 + 0.02 * jax.random.normal(k, (DEPTH, n), f32)

    return {
        "x_prompt": nrm(ks[0], (BATCH, SEQ, D_MODEL)),
        "x_sample": nrm(ks[1], (DEC_BATCH, DEC_SEQ, D_MODEL)),
        "cache_mla_ckv": nrm(ks[2], (DEPTH, DEC_BATCH, PAST_LEN, KV_LORA)),
        "cache_mla_krope": nrm(ks[3], (DEPTH, DEC_BATCH, PAST_LEN, ROPE_DIM)),
        "cache_fox_k": nrm(ks[4], (DEPTH, DEC_BATCH, PAST_LEN, FOX_HEADS, FOX_HEAD_DIM)),
        "cache_fox_v": nrm(ks[5], (DEPTH, DEC_BATCH, PAST_LEN, FOX_HEADS, FOX_HEAD_DIM)),
        "cache_fox_logf": jax.nn.log_sigmoid(3.0 + nrm(ks[6], (DEPTH, DEC_BATCH, PAST_LEN, FOX_HEADS))),
        "g_ffn1_pre": gain(ks[7], D_MODEL),
        "g_ffn1_post": gain(ks[8], D_MODEL),
        "w_ffn1_gu": nrm(ks[9], (DEPTH, D_MODEL, 2 * D_FF), D_MODEL ** -0.5),
        "w_ffn1_down": nrm(ks[10], (DEPTH, D_FF, D_MODEL), D_FF ** -0.5),
        "g_mix_pre": gain(ks[11], D_MODEL),
        "g_mix_post": gain(ks[12], D_MODEL),
        "w_in": nrm(ks[13], (DEPTH, D_MODEL, IN_COLS), D_MODEL ** -0.5),
        "b_forget": 3.0 + 0.1 * nrm(ks[14], (DEPTH, FOX_HEADS)),
        "g_q_latent": gain(ks[15], Q_LORA),
        "w_q_up": nrm(ks[16], (DEPTH, Q_LORA, MLA_HEADS * (NOPE_DIM + ROPE_DIM)), Q_LORA ** -0.5),
        "g_kv_latent": gain(ks[17], KV_LORA),
        "w_kv_up": nrm(ks[18], (DEPTH, KV_LORA, MLA_HEADS * (NOPE_DIM + MLA_V_DIM)), KV_LORA ** -0.5),
        "w_out": nrm(ks[19], (DEPTH, MIX_W, D_MODEL), MIX_W ** -0.5),
        "g_ffn2_pre": gain(ks[20], D_MODEL),
        "g_ffn2_post": gain(ks[21], D_MODEL),
        "w_ffn2_gu": nrm(ks[22], (DEPTH, D_MODEL, 2 * D_FF), D_MODEL ** -0.5),
        "w_ffn2_down": nrm(ks[23], (DEPTH, D_FF, D_MODEL), D_FF ** -0.5),
    }


def reference(x_prompt, x_sample, cache_mla_ckv, cache_mla_krope, cache_fox_k, cache_fox_v, cache_fox_logf,
              g_ffn1_pre, g_ffn1_post, w_ffn1_gu, w_ffn1_down, g_mix_pre, g_mix_post, w_in, b_forget,
              g_q_latent, w_q_up, g_kv_latent, w_kv_up, w_out, g_ffn2_pre, g_ffn2_post, w_ffn2_gu, w_ffn2_down):
    past_len = cache_mla_ckv.shape[2]
    pos_p = jnp.arange(x_prompt.shape[1])
    pos_s = past_len + jnp.arange(x_sample.shape[1])

    xp, xs = x_prompt, x_sample
    rows_p, rows_s = [], []
    for l in range(DEPTH):
        def layer(x, pos, past):
            h = x + 0.5 * _rmsnorm(
                _swiglu(_rmsnorm(x, g_ffn1_pre[l]), w_ffn1_gu[l], w_ffn1_down[l]), g_ffn1_post[l])
            mix, rows = _token_mix(_rmsnorm(h, g_mix_pre[l]), pos, past, w_in[l], b_forget[l],
                                   g_q_latent[l], w_q_up[l], g_kv_latent[l], w_kv_up[l], w_out[l])
            h = h + _rmsnorm(mix, g_mix_post[l])
            h = h + 0.5 * _rmsnorm(
                _swiglu(_rmsnorm(h, g_ffn2_pre[l]), w_ffn2_gu[l], w_ffn2_down[l]), g_ffn2_post[l])
            return h, rows

        xp, rp = layer(xp, pos_p, None)
        xs, rs = layer(xs, pos_s, (cache_mla_ckv[l], cache_mla_krope[l], cache_fox_k[l],
                                   cache_fox_v[l], cache_fox_logf[l]))
        rows_p.append(rp)
        rows_s.append(rs)

    p_ckv, p_krope, p_fk, p_fv, p_logf = [jnp.stack([r[i] for r in rows_p]) for i in range(5)]
    s_ckv, s_krope, s_fk, s_fv, s_logf = [jnp.stack([r[i] for r in rows_s]) for i in range(5)]
    return (xp, xs, p_ckv, p_krope, p_fk, p_fv, p_logf, s_ckv, s_krope, s_fk, s_fv, s_logf)
```

```cpp
#include <hip/hip_runtime.h>
#include <hip/hip_cooperative_groups.h>
#include <cstdio>
#include <cstdint>
namespace cg = cooperative_groups;
namespace pg8 {
#define PG8_LAS __attribute__((address_space(3)))
typedef unsigned short bf16_t;
typedef short bf16x8 __attribute__((ext_vector_type(8)));
typedef float f32x4 __attribute__((ext_vector_type(4)));
typedef unsigned u32x4 __attribute__((ext_vector_type(4)));
constexpr int BM = 256, BK = 64, HALF = 128, HTB = HALF * BK * 2  , STAGE_BYTES = 8 * HTB, NXCD = 8, WGM = 8;

__host__ __device__ __forceinline__ int lds_byte(int r, int c) { const int st = (r >> 4) * 2 + (c >> 5), rr = r & 15, cc = c & 31, ob = rr * 64 + cc * 2; return st * 1024 + (ob ^ (((ob >> 9) & 1) << 5)); }
__host__ __device__ __forceinline__ void stage_rc(int b, int& R, int& C) { const int st = b / 1024, sb = b % 1024, swz = sb ^ (((sb >> 9) & 1) << 5); R = (st >> 1) * 16 + swz / 64; C = (st & 1) * 32 + (swz % 64) / 2; }
__host__ __device__ __forceinline__ int perm32(int rho) { const int n = rho >> 4, i = rho & 15; return 8 * (i >> 2) + 4 * n + (i & 3); }

struct Unit { int pm, pn; };
struct Gemm { const bf16_t* A; const bf16_t* Bt; int M, N, K; };

struct StaticOrder {
    int nM, nN, nwg, G, c;
    __host__ __device__ void init(int M, int N, int G_, int c_) { nM = M / BM; nN = N / BM; nwg = nM * nN; G = G_; c = c_; }
    __host__ __device__ bool next(int i, Unit& u) const {
        const long L = (long)i * G + c; if (L >= nwg) return false;
        int wgid = (int)L; { const int q = nwg / NXCD, r = nwg % NXCD, xcd = wgid % NXCD, off = wgid / NXCD; wgid = (xcd < r ? xcd * (q + 1) : r * (q + 1) + (xcd - r) * q) + off; }
        const int nig = WGM * nN, gid = wgid / nig, fm = gid * WGM, gsz = (nM - fm) < WGM ? (nM - fm) : WGM;
        u.pm = fm + ((wgid % nig) % gsz); u.pn = (wgid % nig) / gsz; return true;
    }
    __device__ __forceinline__ void a_ready(const Unit&) const {}
    __device__ __forceinline__ void done(const Unit&) const {}
};

__device__ __forceinline__ unsigned cvt_pk_bf16(float lo, float hi) { unsigned r; asm volatile("v_cvt_pk_bf16_f32 %0, %1, %2" : "=v"(r) : "v"(lo), "v"(hi)); return r; }
typedef float f32x2 __attribute__((ext_vector_type(2)));
struct EpiStore {
    static constexpr bool PERM = true, AFTER_DRAIN = false;
    bf16_t* O; int ldc;
    __device__ __forceinline__ void operator()(const f32x4 (&acc)[2][2][4][2], const Unit& u, int wr, int wc, int fr, int fq) const {
        const int row0 = u.pm * BM + wr * 64 + fr, col0 = u.pn * BM + wc * 32 + 8 * fq;
#pragma unroll
        for (int ai = 0; ai < 2; ++ai)
#pragma unroll
            for (int m = 0; m < 4; ++m) { bf16_t* rowp = O + (size_t)(row0 + ai * HALF + m * 16) * ldc + col0;
#pragma unroll
                for (int bj = 0; bj < 2; ++bj) { const f32x4 v0 = acc[ai][bj][m][0], v1 = acc[ai][bj][m][1];
                    u32x4 w; w.x = cvt_pk_bf16(v0[0], v0[1]); w.y = cvt_pk_bf16(v0[2], v0[3]); w.z = cvt_pk_bf16(v1[0], v1[1]); w.w = cvt_pk_bf16(v1[2], v1[3]);
                    *(u32x4*)(rowp + bj * HALF) = w; } }
    }
};
__device__ __forceinline__ float silu_mul(float g, float u) { return g * u * __builtin_amdgcn_rcpf(1.0f + __builtin_amdgcn_exp2f(-1.4426950408889634f * g)); }
struct EpiSwiGLU {
    static constexpr bool PERM = true, AFTER_DRAIN = false;
    bf16_t* O; int ldc;
    __device__ __forceinline__ void operator()(const f32x4 (&acc)[2][2][4][2], const Unit& u, int wr, int wc, int fr, int fq) const {
        const int row0 = u.pm * BM + wr * 64 + fr, col0 = u.pn * HALF + wc * 32 + 8 * fq;
#pragma unroll
        for (int ai = 0; ai < 2; ++ai)
#pragma unroll
            for (int m = 0; m < 4; ++m) { bf16_t* rowp = O + (size_t)(row0 + ai * HALF + m * 16) * ldc + col0;
                const f32x4 g0 = acc[ai][0][m][0], g1 = acc[ai][0][m][1], u0 = acc[ai][1][m][0], u1 = acc[ai][1][m][1];
                u32x4 w; w.x = cvt_pk_bf16(silu_mul(g0[0], u0[0]), silu_mul(g0[1], u0[1])); w.y = cvt_pk_bf16(silu_mul(g0[2], u0[2]), silu_mul(g0[3], u0[3]));
                w.z = cvt_pk_bf16(silu_mul(g1[0], u1[0]), silu_mul(g1[1], u1[1])); w.w = cvt_pk_bf16(silu_mul(g1[2], u1[2]), silu_mul(g1[3], u1[3]));
                *(u32x4*)rowp = w; }
    }
};
template <class Epi, class Sched, bool ALIGN_EPI = false, bool SP2 = false>
__device__ __forceinline__ void gemm_phase(PG8_LAS unsigned char* lds, const Gemm g, const Sched& S, const Epi& E) {
    int tid_ = threadIdx.x; asm volatile("" : "+v"(tid_));
    const int tid = tid_, wid = __builtin_amdgcn_readfirstlane(tid >> 6), lane = tid & 63, wr = wid >> 2, wc = wid & 3, fr = lane & 15, fq = lane >> 4;
    const int K = g.K, nt = K / BK;
    unsigned voffA[2], voffB[2];
#pragma unroll
    for (int i = 0; i < 2; ++i) { int R, C; stage_rc(tid * 16 + i * 8192, R, C); const int Rb = Epi::PERM ? ((R & ~31) + perm32(R & 31)) : R;
        voffA[i] = (unsigned)(R * K + C) * 2u; voffB[i] = (unsigned)(Rb * K + C) * 2u; }
    const size_t kstep = (size_t)(BK * 2);
    const size_t hstep = (size_t)HALF * K * 2;
    const size_t tstep = 2 * hstep;
    const unsigned ldsw = (unsigned)wid * 1024u;
    const int aoff = lds_byte(wr * 64 + fr, fq * 8), boff = lds_byte(wc * 32 + fr, fq * 8);
#define PG8_SA(b, h) (((b) * 2 + (h)) * HTB)
#define PG8_SB(b, h) ((4 + (b) * 2 + (h)) * HTB)
#define PG8_STAGE(bufoff, gbase, voff) do { _Pragma("unroll") for (int _i = 0; _i < 2; ++_i) \
        __builtin_amdgcn_global_load_lds((const unsigned*)((const char*)(gbase) + (voff)[_i]), (PG8_LAS unsigned*)(lds + (bufoff) + ldsw + _i * 8192), 16, 0, 0); } while (0)
#define PG8_LDA(dst, b, h) do { _Pragma("unroll") for (int m = 0; m < 4; ++m) _Pragma("unroll") for (int k = 0; k < 2; ++k) dst[m][k] = *(const PG8_LAS bf16x8*)(lds + PG8_SA(b, h) + aoff + m * 2048 + k * 1024); } while (0)
#define PG8_LDB(dst, b, h) do { _Pragma("unroll") for (int n = 0; n < 2; ++n) _Pragma("unroll") for (int k = 0; k < 2; ++k) dst[n][k] = *(const PG8_LAS bf16x8*)(lds + PG8_SB(b, h) + boff + n * 2048 + k * 1024); } while (0)
#define PG8_MMA(ai, bj, At, Bt) do { __builtin_amdgcn_s_setprio(1); _Pragma("unroll") for (int m = 0; m < 4; ++m) _Pragma("unroll") for (int n = 0; n < 2; ++n) _Pragma("unroll") for (int k = 0; k < 2; ++k) \
        acc[ai][bj][m][n] = __builtin_amdgcn_mfma_f32_16x16x32_bf16(Bt[n][k], At[m][k], acc[ai][bj][m][n], 0, 0, 0); __builtin_amdgcn_s_setprio(0); } while (0)
#define PG8_WAIT_V(n) asm volatile("s_waitcnt vmcnt(" #n ")" ::: "memory")
#define PG8_WAIT_L(n) asm volatile("s_waitcnt lgkmcnt(" #n ")" ::: "memory")
#define PG8_BAR __builtin_amdgcn_s_barrier()
#define PG8_SCHED __builtin_amdgcn_sched_barrier(0)
    Unit cur, nxt; int ui = 0;
    if (!S.next(0, cur)) return;
    f32x4 acc[2][2][4][2];
#pragma unroll
    for (int a = 0; a < 2; ++a)
#pragma unroll
        for (int b = 0; b < 2; ++b)
#pragma unroll
            for (int m = 0; m < 4; ++m)
#pragma unroll
                for (int n = 0; n < 2; ++n) acc[a][b][m][n] = (f32x4){0.f, 0.f, 0.f, 0.f};
    bf16x8 At[4][2], B0[2][2], B1[2][2];
    const char* cA = (const char*)g.A + (size_t)cur.pm * tstep; const char* cB = (const char*)g.Bt + (size_t)cur.pn * tstep;
    S.a_ready(cur);
    if constexpr (SP2) {
        PG8_STAGE(PG8_SB(0, 0), cB, voffB); PG8_STAGE(PG8_SB(0, 1), cB + hstep, voffB); PG8_STAGE(PG8_SA(0, 0), cA, voffA); PG8_STAGE(PG8_SA(0, 1), cA + hstep, voffA);
        if (wr == 1) PG8_BAR;
        PG8_WAIT_V(2); PG8_BAR;
        PG8_STAGE(PG8_SB(1, 0), cB + kstep, voffB); PG8_STAGE(PG8_SA(1, 0), cA + kstep, voffA); PG8_STAGE(PG8_SB(1, 1), cB + hstep + kstep, voffB);
        PG8_WAIT_V(6); PG8_BAR;
    } else {
        PG8_STAGE(PG8_SB(0, 0), cB, voffB); PG8_STAGE(PG8_SA(0, 0), cA, voffA); PG8_STAGE(PG8_SB(0, 1), cB + hstep, voffB); PG8_STAGE(PG8_SA(0, 1), cA + hstep, voffA);
        if (wr == 1) PG8_BAR;
        PG8_WAIT_V(4); PG8_BAR;
        PG8_STAGE(PG8_SB(1, 0), cB + kstep, voffB); PG8_STAGE(PG8_SA(1, 0), cA + kstep, voffA); PG8_STAGE(PG8_SB(1, 1), cB + hstep + kstep, voffB);
        PG8_WAIT_V(6); PG8_BAR;
    }
    for (;;) {
        const bool has_next = S.next(ui + 1, nxt);
        const char* nA = has_next ? (const char*)g.A + (size_t)nxt.pm * tstep : cA; const char* nB = has_next ? (const char*)g.Bt + (size_t)nxt.pn * tstep : cB;
        for (int t = 0; t < nt; t += 2) {
            const bool last = (t == nt - 2);
            const char* a1 = cA + (size_t)(t + 1) * kstep;
            const char* a2 = last ? nA : cA + (size_t)(t + 2) * kstep; const char* b2 = last ? nB : cB + (size_t)(t + 2) * kstep;
            const char* a3 = a2 + kstep; const char* b3 = b2 + kstep;
            if (last && has_next) S.a_ready(nxt);
            if constexpr (SP2) {
            PG8_LDB(B0, 0, 0); PG8_LDB(B1, 0, 1); PG8_SCHED; PG8_LDA(At, 0, 0); PG8_STAGE(PG8_SA(1, 1), a1 + hstep, voffA);
            PG8_WAIT_V(8); PG8_WAIT_L(0); PG8_BAR; PG8_MMA(0, 0, At, B0); PG8_MMA(0, 1, At, B1); PG8_BAR; PG8_SCHED;
            PG8_LDA(At, 0, 1); PG8_STAGE(PG8_SB(0, 0), b2, voffB); PG8_STAGE(PG8_SB(0, 1), b2 + hstep, voffB); PG8_STAGE(PG8_SA(0, 0), a2, voffA);
            PG8_WAIT_V(8); PG8_WAIT_L(0); PG8_BAR; PG8_MMA(1, 0, At, B0); PG8_MMA(1, 1, At, B1); PG8_BAR; PG8_SCHED;
            PG8_LDB(B0, 1, 0); PG8_LDB(B1, 1, 1); PG8_SCHED; PG8_LDA(At, 1, 0); PG8_STAGE(PG8_SA(0, 1), a2 + hstep, voffA);
            PG8_WAIT_V(8); PG8_WAIT_L(0); PG8_BAR; PG8_MMA(0, 0, At, B0); PG8_MMA(0, 1, At, B1); PG8_BAR; PG8_SCHED;
            PG8_LDA(At, 1, 1); PG8_STAGE(PG8_SB(1, 0), b3, voffB); PG8_STAGE(PG8_SB(1, 1), b3 + hstep, voffB); PG8_STAGE(PG8_SA(1, 0), a3, voffA);
            PG8_WAIT_V(8); PG8_WAIT_L(0); PG8_BAR; PG8_MMA(1, 0, At, B0); PG8_MMA(1, 1, At, B1); PG8_BAR; PG8_SCHED;
            } else {
            PG8_LDB(B0, 0, 0); PG8_SCHED; PG8_LDA(At, 0, 0); PG8_STAGE(PG8_SA(1, 1), a1 + hstep, voffA);
            PG8_WAIT_L(8); PG8_BAR; PG8_WAIT_L(0); PG8_MMA(0, 0, At, B0); PG8_BAR; PG8_SCHED;
            PG8_LDB(B1, 0, 1); PG8_STAGE(PG8_SB(0, 0), b2, voffB);
            PG8_BAR; PG8_WAIT_L(0); PG8_MMA(0, 1, At, B1); PG8_BAR;
            PG8_LDA(At, 0, 1); PG8_STAGE(PG8_SA(0, 0), a2, voffA);
            PG8_BAR; PG8_WAIT_L(0); PG8_MMA(1, 0, At, B0); PG8_BAR; PG8_SCHED;
            PG8_STAGE(PG8_SB(0, 1), b2 + hstep, voffB);
            PG8_WAIT_V(6); PG8_BAR; PG8_MMA(1, 1, At, B1); PG8_BAR;
            PG8_LDB(B0, 1, 0); PG8_SCHED; PG8_LDA(At, 1, 0); PG8_STAGE(PG8_SA(0, 1), a2 + hstep, voffA);
            PG8_WAIT_L(8); PG8_BAR; PG8_WAIT_L(0); PG8_MMA(0, 0, At, B0); PG8_BAR; PG8_SCHED;
            PG8_LDB(B1, 1, 1); PG8_STAGE(PG8_SB(1, 0), b3, voffB);
            PG8_BAR; PG8_WAIT_L(0); PG8_MMA(0, 1, At, B1); PG8_BAR;
            PG8_LDA(At, 1, 1); PG8_STAGE(PG8_SA(1, 0), a3, voffA);
            PG8_BAR; PG8_WAIT_L(0); PG8_MMA(1, 0, At, B0); PG8_BAR; PG8_SCHED;
            PG8_STAGE(PG8_SB(1, 1), b3 + hstep, voffB);
            PG8_WAIT_V(6); PG8_BAR; PG8_MMA(1, 1, At, B1); PG8_BAR;
            }
        }
        if constexpr (ALIGN_EPI) { if (wr == 0) PG8_BAR; }
        if constexpr (!Epi::AFTER_DRAIN) { E(acc, cur, wr, wc, fr, fq); S.done(cur); }
        if (!has_next) break;
#pragma unroll
        for (int a = 0; a < 2; ++a)
#pragma unroll
            for (int b = 0; b < 2; ++b)
#pragma unroll
                for (int m = 0; m < 4; ++m)
#pragma unroll
                    for (int n = 0; n < 2; ++n) acc[a][b][m][n] = (f32x4){0.f, 0.f, 0.f, 0.f};
        cur = nxt; cA = nA; cB = nB; ++ui;
        if constexpr (ALIGN_EPI) { if (wr == 1) PG8_BAR; }
    }
    PG8_WAIT_V(0);
    if constexpr (!ALIGN_EPI) { if (wr == 0) PG8_BAR; }
    PG8_BAR;
    if constexpr (Epi::AFTER_DRAIN) { E.fused(acc, cur, wr, wc, fr, fq, lds, wid, lane); S.done(cur); }
#undef PG8_SA
#undef PG8_SB
#undef PG8_STAGE
#undef PG8_LDA
#undef PG8_LDB
#undef PG8_MMA
#undef PG8_WAIT_V
#undef PG8_WAIT_L
#undef PG8_BAR
#undef PG8_SCHED
}
}

#define LAS __attribute__((address_space(3)))
#define GAS __attribute__((address_space(1)))
typedef unsigned short bf16;
typedef float f32x4 __attribute__((ext_vector_type(4)));
typedef float f32x16 __attribute__((ext_vector_type(16)));
typedef short bf16x8 __attribute__((ext_vector_type(8)));
typedef short s16x4 __attribute__((ext_vector_type(4)));
typedef unsigned u32x4 __attribute__((ext_vector_type(4)));
typedef unsigned u32x2 __attribute__((ext_vector_type(2)));

constexpr int DM = 1024, NP = 65536, NS = 128, NTOK = NP + NS, MPAD = 65792;
constexpr int SEQ = 8192, PAST = 4096, DSEQ = 16, SKEYS = PAST + DSEQ;
constexpr int KROWS = NP + 8 * SKEYS, KPAD = 98560;
constexpr int DFF = 2816, NGU = 2 * DFF, NIN = 2216, NINP = 2304, QLORA = 384, KVLORA = 256, NQ = 768, NKV = 1024;
constexpr int C_CKV = 384, C_KR = 640, C_FQ = 672, C_FK = 1184, C_FV = 1696, C_FG = 2208;
constexpr float EPS = 1e-6f, LOG2E = 1.4426950408889634f;

constexpr size_t O_Y = 0, O_CKVP = (size_t)NTOK * DM, O_KRP = O_CKVP + (size_t)NP * 256, O_FKP = O_KRP + (size_t)NP * 32, O_FVP = O_FKP + (size_t)NP * 512,
                 O_LFP = O_FVP + (size_t)NP * 512, O_CKVS = O_LFP + (size_t)NP * 8, O_KRS = O_CKVS + (size_t)NS * 256, O_FKS = O_KRS + (size_t)NS * 32,
                 O_FVS = O_FKS + (size_t)NS * 512, O_LFS = O_FVS + (size_t)NS * 512, O_END = O_LFS + (size_t)NS * 8;

constexpr size_t al256(size_t x) { return (x + 255) & ~(size_t)255; }
constexpr size_t WS_WGU1 = 0, WS_WD1 = WS_WGU1 + al256((size_t)NGU * DM * 2), WS_WGU2 = WS_WD1 + al256((size_t)DM * DFF * 2), WS_WD2 = WS_WGU2 + al256((size_t)NGU * DM * 2),
                 WS_WIN = WS_WD2 + al256((size_t)DM * DFF * 2), WS_WQ = WS_WIN + al256((size_t)NINP * DM * 2), WS_WKV = WS_WQ + al256((size_t)NQ * QLORA * 2),
                 WS_WO = WS_WKV + al256((size_t)NKV * KVLORA * 2), WS_TAB = WS_WO + al256((size_t)DM * DM * 2), WS_LK = WS_TAB + al256((size_t)SEQ * 16 * 8),
                 WS_LFS = WS_LK + al256((size_t)KPAD * 8 * 4), WS_KROPE = WS_LFS + al256((size_t)8 * SKEYS * 8 * 4), WS_XN = WS_KROPE + al256((size_t)KPAD * 32 * 2),
                 WS_D = WS_XN + al256((size_t)MPAD * DM * 2), WS_ACT = WS_D + al256((size_t)MPAD * DM * 2), WS_QM = WS_ACT + al256((size_t)MPAD * DFF * 2),
                 WS_KV = WS_QM + al256((size_t)MPAD * NQ * 2), WS_QCTR = WS_KV + al256((size_t)KPAD * NKV * 2), WS_BAR = WS_QCTR + 4096, WS_END = WS_BAR + 16384;
constexpr size_t WS_PROJ = WS_ACT, WS_CQN = WS_PROJ + al256((size_t)MPAD * NINP * 2);
constexpr size_t WS_CKVN = WS_D, WS_FKS = WS_CKVN + al256((size_t)KPAD * KVLORA * 2), WS_FVS = WS_FKS + al256((size_t)(8 * SKEYS + 64) * 512 * 2);
static_assert(WS_CQN + (size_t)MPAD * QLORA * 2 <= WS_QM, "overlay 1");
static_assert(WS_FVS + (size_t)(8 * SKEYS + 64) * 512 * 2 <= WS_ACT, "overlay 2");

constexpr int LDS_BYTES = 135168;

struct Args { const float* in[24]; float* out; unsigned char* ws; };
constexpr int PTR_OFF = 131072;
struct Ctx {
    LAS unsigned char* lds;
    __device__ __forceinline__ unsigned long long raw(int i) const { const unsigned long long v = *(const LAS unsigned long long*)(lds + PTR_OFF + 8 * i);
        const unsigned lo = __builtin_amdgcn_readfirstlane((unsigned)v), hi = __builtin_amdgcn_readfirstlane((unsigned)(v >> 32)); return ((unsigned long long)hi << 32) | lo; }
    __device__ __forceinline__ const float* in(int i) const { return (const float*)raw(i); }
    __device__ __forceinline__ float* out() const { return (float*)raw(24); }
    __device__ __forceinline__ unsigned char* ws() const { return (unsigned char*)raw(25); }
};
enum { I_XP = 0, I_XS, I_CCKV, I_CKR, I_CFK, I_CFV, I_CLF, I_G1PRE, I_G1POST, I_W1GU, I_W1D, I_GMPRE, I_GMPOST, I_WIN, I_BF, I_GQ, I_WQ, I_GKV, I_WKV, I_WO, I_G2PRE, I_G2POST, I_W2GU, I_W2D };

__device__ __forceinline__ unsigned f2bf(float f) { unsigned u = __builtin_bit_cast(unsigned, f); return (u + 0x7fffu + ((u >> 16) & 1u)) >> 16; }
__device__ __forceinline__ unsigned pk2(float lo, float hi) { return pg8::cvt_pk_bf16(lo, hi); }
__device__ __forceinline__ float bf2f(unsigned short b) { return __builtin_bit_cast(float, (unsigned)b << 16); }
__device__ __forceinline__ float bflo(unsigned w) { return __builtin_bit_cast(float, w << 16); }
__device__ __forceinline__ float bfhi(unsigned w) { return __builtin_bit_cast(float, w & 0xffff0000u); }
__device__ __forceinline__ float wave_sum(float v) {
#pragma unroll
    for (int o = 1; o < 64; o <<= 1) v += __shfl_xor(v, o);
    return v;
}
__device__ __forceinline__ int keyrow(int n) { return n < NP ? n : NP + ((n - NP) >> 4) * SKEYS + PAST + ((n - NP) & 15); }
__device__ __forceinline__ int rowpos(int n) { return n < NP ? (n & (SEQ - 1)) : PAST + ((n - NP) & 15); }

struct MapId  { __device__ __forceinline__ int col(int c) const { return c; } };
struct MapGU  { __device__ __forceinline__ int col(int c) const { return ((c >> 7) & 1) * DFF + (c >> 8) * 128 + (c & 127); } };
struct MapIn  { __device__ __forceinline__ int col(int c) const { return c < NIN ? c : -1; } };
struct MapQ   { __device__ __forceinline__ int col(int c) const { const int h = c / 96, w = c % 96; if (w < 64) return c; const int p = w - 64; return h * 96 + 64 + ((p & 1) ? (p >> 1) + 16 : (p >> 1)); } };
template <class Map> __device__ __forceinline__ void transpose_w(const float* W, int K, int Nsrc, bf16* WT, int Ndst, Map map, LAS float* scr, int gw, int NGW, int lane) {
    const int nblk = Ndst / 32, items = (K / 64) * nblk;
    for (int it = gw; it < items; it += NGW) {
        const int kb = it / nblk, nb = it % nblk, k0 = 64 * kb, n0 = 32 * nb;
        const int sc = map.col(n0 + (lane & 31));
#pragma unroll 8
        for (int i = 0; i < 32; ++i) { const int kk = 2 * i + (lane >> 5); scr[kk * 33 + (lane & 31)] = sc >= 0 ? W[(size_t)(k0 + kk) * Nsrc + sc] : 0.f; }
        asm volatile("s_waitcnt lgkmcnt(0)" ::: "memory");
        const int c = lane & 7;
#pragma unroll
        for (int j = 0; j < 4; ++j) { const int n = (lane >> 3) + 8 * j; const LAS float* s = scr + (8 * c) * 33 + n;
            u32x4 o; o.x = pk2(s[0 * 33], s[1 * 33]); o.y = pk2(s[2 * 33], s[3 * 33]); o.z = pk2(s[4 * 33], s[5 * 33]); o.w = pk2(s[6 * 33], s[7 * 33]);
            *(u32x4*)(WT + (size_t)(n0 + n) * K + k0 + 8 * c) = o; }
        asm volatile("s_waitcnt lgkmcnt(0)" ::: "memory");
    }
}
__device__ __forceinline__ void rope_cs(int pos, int i, float& c, float& s) {
    double f = 1.0; for (int k = 0; k < i; ++k) f *= 0.56234132519034908;
    const double ang = (double)pos * f;
    const double q = __builtin_rint(ang * 0.63661977236758134);
    const double y = (ang - q * 1.5707963267948966) - q * 6.123233995736766e-17;
    const double y2 = y * y;
    const double sn = y * (1.0 + y2 * (-1.0 / 6 + y2 * (1.0 / 120 + y2 * (-1.0 / 5040 + y2 * (1.0 / 362880 + y2 * (-1.0 / 39916800 + y2 * (1.0 / 6227020800.0)))))));
    const double cs = 1.0 + y2 * (-0.5 + y2 * (1.0 / 24 + y2 * (-1.0 / 720 + y2 * (1.0 / 40320 + y2 * (-1.0 / 3628800 + y2 * (1.0 / 479001600 + y2 * (-1.0 / 87178291200.0)))))));
    const int qi = (int)((long long)q & 3);
    const double cc = (qi == 0) ? cs : (qi == 1) ? -sn : (qi == 2) ? -cs : sn;
    const double ss = (qi == 0) ? sn : (qi == 1) ? cs : (qi == 2) ? -sn : -cs;
    c = (float)cc; s = (float)ss;
}

__device__ __forceinline__ void load16_f32(const float* p, int lane, float (&v)[16]) {
#pragma unroll
    for (int j = 0; j < 2; ++j) { const f32x4 a = *(const f32x4*)(p + 8 * lane + 512 * j), b = *(const f32x4*)(p + 8 * lane + 512 * j + 4);
        v[8 * j + 0] = a[0]; v[8 * j + 1] = a[1]; v[8 * j + 2] = a[2]; v[8 * j + 3] = a[3]; v[8 * j + 4] = b[0]; v[8 * j + 5] = b[1]; v[8 * j + 6] = b[2]; v[8 * j + 7] = b[3]; }
}
__device__ __forceinline__ void load16_bf16(const bf16* p, int lane, float (&v)[16]) {
#pragma unroll
    for (int j = 0; j < 2; ++j) { const u32x4 a = *(const u32x4*)(p + 8 * lane + 512 * j);
        v[8 * j + 0] = bflo(a.x); v[8 * j + 1] = bfhi(a.x); v[8 * j + 2] = bflo(a.y); v[8 * j + 3] = bfhi(a.y); v[8 * j + 4] = bflo(a.z); v[8 * j + 5] = bfhi(a.z); v[8 * j + 6] = bflo(a.w); v[8 * j + 7] = bfhi(a.w); }
}
__device__ __forceinline__ void store16_f32(float* p, int lane, const float (&v)[16]) {
#pragma unroll
    for (int j = 0; j < 2; ++j) { *(f32x4*)(p + 8 * lane + 512 * j) = (f32x4){v[8 * j], v[8 * j + 1], v[8 * j + 2], v[8 * j + 3]}; *(f32x4*)(p + 8 * lane + 512 * j + 4) = (f32x4){v[8 * j + 4], v[8 * j + 5], v[8 * j + 6], v[8 * j + 7]}; }
}
__device__ __forceinline__ void store16_f32_nt(float* p, int lane, const float (&v)[16]) {
#pragma unroll
    for (int j = 0; j < 2; ++j) { __builtin_nontemporal_store((f32x4){v[8 * j], v[8 * j + 1], v[8 * j + 2], v[8 * j + 3]}, (f32x4*)(p + 8 * lane + 512 * j)); __builtin_nontemporal_store((f32x4){v[8 * j + 4], v[8 * j + 5], v[8 * j + 6], v[8 * j + 7]}, (f32x4*)(p + 8 * lane + 512 * j + 4)); }
}
__device__ __forceinline__ void store16_bf16(bf16* p, int lane, const float (&v)[16]) {
#pragma unroll
    for (int j = 0; j < 2; ++j) { u32x4 o; o.x = pk2(v[8 * j], v[8 * j + 1]); o.y = pk2(v[8 * j + 2], v[8 * j + 3]); o.z = pk2(v[8 * j + 4], v[8 * j + 5]); o.w = pk2(v[8 * j + 6], v[8 * j + 7]); *(u32x4*)(p + 8 * lane + 512 * j) = o; }
}
__device__ __forceinline__ float ssq16(const float (&v)[16]) { float s = 0.f;
#pragma unroll
    for (int i = 0; i < 16; ++i) s += v[i] * v[i];
    return wave_sum(s); }
__device__ __forceinline__ void rp_norm_only(const Ctx& a, const float* g, bf16* XN, int gw, int NGW, int lane) {
    float gv[16]; load16_f32(g, lane, gv); const float* xp = a.in(I_XP); const float* xs = a.in(I_XS);
    for (int n = gw; n < NTOK; n += NGW) {
        const float* xr = n < NP ? xp + (size_t)n * DM : xs + (size_t)(n - NP) * DM;
        float v[16]; load16_f32(xr, lane, v);
        const float rs = 1.0f / sqrtf(ssq16(v) * (1.0f / DM) + EPS);
#pragma unroll
        for (int i = 0; i < 16; ++i) v[i] = v[i] * rs * gv[i];
        store16_bf16(XN + (size_t)n * DM, lane, v);
    }
}
__device__ __forceinline__ void rp_residual(const Ctx& a, bool base_is_x, bool final_y, const bf16* D, float coef, const float* gpost, const float* gnext, float* hout, bf16* XN, int n0, int n1, int gw, int NGW, int lane) {
    const float* xp = a.in(I_XP); const float* xs = a.in(I_XS);
    for (int n = n0 + gw; n < n1; n += NGW) {
        float v[16], d[16], g[16];
        if (base_is_x) load16_f32(n < NP ? xp + (size_t)n * DM : xs + (size_t)(n - NP) * DM, lane, v); else load16_bf16((const bf16*)(hout + (size_t)n * DM), lane, v);
        load16_bf16(D + (size_t)n * DM, lane, d); load16_f32(gpost, lane, g);
        const float rs = coef / sqrtf(ssq16(d) * (1.0f / DM) + EPS);
#pragma unroll
        for (int i = 0; i < 16; ++i) v[i] = v[i] + d[i] * rs * g[i];
        if (final_y) store16_f32_nt(hout + (size_t)n * DM, lane, v); else store16_bf16((bf16*)(hout + (size_t)n * DM), lane, v);
        if (gnext) {
            load16_f32(gnext, lane, g);
            const float rs2 = 1.0f / sqrtf(ssq16(v) * (1.0f / DM) + EPS);
#pragma unroll
            for (int i = 0; i < 16; ++i) v[i] = v[i] * rs2 * g[i];
            store16_bf16(XN + (size_t)n * DM, lane, v);
        }
    }
}
__device__ __forceinline__ void rp_mix(const Ctx& a, int n0, int n1, bool do_cache, int gw, int NGW, int lane) {
    unsigned char* ws = a.ws(); float* out = a.out();
    const bf16* PROJ = (const bf16*)(ws + WS_PROJ); bf16* CQN = (bf16*)(ws + WS_CQN); bf16* CKVN = (bf16*)(ws + WS_CKVN); bf16* KROPE = (bf16*)(ws + WS_KROPE);
    bf16* FKS = (bf16*)(ws + WS_FKS); bf16* FVS = (bf16*)(ws + WS_FVS); float* LFS = (float*)(ws + WS_LFS); const float* TAB = (const float*)(ws + WS_TAB);
    const float* gq = a.in(I_GQ); const float* gkv = a.in(I_GKV); const float* bfg = a.in(I_BF);
    for (int n = n0 + gw; n < n1; n += NGW) {
        const bf16* pr = PROJ + (size_t)n * NINP; const bool smp = n >= NP; const int ns = n - NP; const int kr = keyrow(n);
        { const unsigned* p = (const unsigned*)(pr + 6 * lane); const unsigned w0 = p[0], w1 = p[1], w2 = p[2];
          float v[6] = {bflo(w0), bfhi(w0), bflo(w1), bfhi(w1), bflo(w2), bfhi(w2)}; float s = 0.f;
#pragma unroll
          for (int i = 0; i < 6; ++i) s += v[i] * v[i];
          const float rs = 1.0f / sqrtf(wave_sum(s) * (1.0f / QLORA) + EPS);
#pragma unroll
          for (int i = 0; i < 6; ++i) v[i] = v[i] * rs * gq[6 * lane + i];
          unsigned* o = (unsigned*)(CQN + (size_t)n * QLORA + 6 * lane); o[0] = pk2(v[0], v[1]); o[1] = pk2(v[2], v[3]); o[2] = pk2(v[4], v[5]); }
        { const u32x2 w = *(const u32x2*)(pr + C_CKV + 4 * lane); float v[4] = {bflo(w.x), bfhi(w.x), bflo(w.y), bfhi(w.y)};
          const float rs = 1.0f / sqrtf(wave_sum(v[0] * v[0] + v[1] * v[1] + v[2] * v[2] + v[3] * v[3]) * (1.0f / KVLORA) + EPS);
          const f32x4 g = *(const f32x4*)(gkv + 4 * lane); const f32x4 r = {v[0] * rs * g[0], v[1] * rs * g[1], v[2] * rs * g[2], v[3] * rs * g[3]};
          __builtin_nontemporal_store(r, (f32x4*)(out + (smp ? O_CKVS + (size_t)ns * 256 : O_CKVP + (size_t)n * 256) + 4 * lane));
          u32x2 o; o.x = pk2(r[0], r[1]); o.y = pk2(r[2], r[3]); *(u32x2*)(CKVN + (size_t)kr * KVLORA + 4 * lane) = o; }
        if (lane < 16) { const float x1 = bf2f(pr[C_KR + lane]), x2 = bf2f(pr[C_KR + 16 + lane]); const int pos = rowpos(n);
          const float c = TAB[((size_t)pos * 16 + lane) * 2], s = TAB[((size_t)pos * 16 + lane) * 2 + 1];
          const float o1 = x1 * c - x2 * s, o2 = x1 * s + x2 * c; float* kr_out = out + (smp ? O_KRS + (size_t)ns * 32 : O_KRP + (size_t)n * 32);
          kr_out[lane] = o1; kr_out[16 + lane] = o2; *(unsigned*)(KROPE + (size_t)kr * 32 + 2 * lane) = pk2(o1, o2); }
        { const u32x4 wk = *(const u32x4*)(pr + C_FK + 8 * lane), wv = *(const u32x4*)(pr + C_FV + 8 * lane);
          float* ko = out + (smp ? O_FKS + (size_t)ns * 512 : O_FKP + (size_t)n * 512) + 8 * lane; float* vo = out + (smp ? O_FVS + (size_t)ns * 512 : O_FVP + (size_t)n * 512) + 8 * lane;
          __builtin_nontemporal_store((f32x4){bflo(wk.x), bfhi(wk.x), bflo(wk.y), bfhi(wk.y)}, (f32x4*)ko); __builtin_nontemporal_store((f32x4){bflo(wk.z), bfhi(wk.z), bflo(wk.w), bfhi(wk.w)}, (f32x4*)(ko + 4));
          __builtin_nontemporal_store((f32x4){bflo(wv.x), bfhi(wv.x), bflo(wv.y), bfhi(wv.y)}, (f32x4*)vo); __builtin_nontemporal_store((f32x4){bflo(wv.z), bfhi(wv.z), bflo(wv.w), bfhi(wv.w)}, (f32x4*)(vo + 4));
          if (smp) { *(u32x4*)(FKS + (size_t)(kr - NP) * 512 + 8 * lane) = wk; *(u32x4*)(FVS + (size_t)(kr - NP) * 512 + 8 * lane) = wv; } }
        if (lane < 8) { const float z = bf2f(pr[C_FG + lane]) + bfg[lane]; const float lf = fminf(z, 0.f) - log1pf(expf(-fabsf(z)));
          out[(smp ? O_LFS + (size_t)ns * 8 : O_LFP + (size_t)n * 8) + lane] = lf; if (smp) LFS[(size_t)(kr - NP) * 8 + lane] = lf; }
    }
    if (!do_cache) return;
    int lane_ = lane; asm volatile("" : "+v"(lane_));
    const unsigned gt = (unsigned)gw * 64u + (unsigned)lane_, NT = (unsigned)NGW * 64u;
    { const float* src = a.in(I_CCKV);
      for (unsigned e = gt; e < 8u * PAST * 256 / 8; e += NT) { const unsigned row = e >> 5, c = (e & 31) * 8; const unsigned b = row >> 12, j = row & 4095;
        const f32x4 x = *(const f32x4*)(src + (size_t)row * 256 + c), y = *(const f32x4*)(src + (size_t)row * 256 + c + 4);
        u32x4 o; o.x = pk2(x[0], x[1]); o.y = pk2(x[2], x[3]); o.z = pk2(y[0], y[1]); o.w = pk2(y[2], y[3]); *(u32x4*)(CKVN + ((size_t)NP + b * SKEYS + j) * 256 + c) = o; } }
    { const float* srck = a.in(I_CFK); const float* srcv = a.in(I_CFV);
      for (unsigned e = gt; e < 8u * PAST * 512 / 8; e += NT) { const unsigned row = e >> 6, c = (e & 63) * 8; const unsigned b = row >> 12, j = row & 4095;
        f32x4 x = *(const f32x4*)(srck + (size_t)row * 512 + c), y = *(const f32x4*)(srck + (size_t)row * 512 + c + 4);
        u32x4 o; o.x = pk2(x[0], x[1]); o.y = pk2(x[2], x[3]); o.z = pk2(y[0], y[1]); o.w = pk2(y[2], y[3]); *(u32x4*)(FKS + (size_t)(b * SKEYS + j) * 512 + c) = o;
        x = *(const f32x4*)(srcv + (size_t)row * 512 + c); y = *(const f32x4*)(srcv + (size_t)row * 512 + c + 4);
        o.x = pk2(x[0], x[1]); o.y = pk2(x[2], x[3]); o.z = pk2(y[0], y[1]); o.w = pk2(y[2], y[3]); *(u32x4*)(FVS + (size_t)(b * SKEYS + j) * 512 + c) = o; } }
    { const float* src = a.in(I_CKR);
      for (unsigned e = gt; e < 8u * PAST * 16; e += NT) { const unsigned row = e >> 4, i = e & 15; const unsigned b = row >> 12, j = row & 4095;
        *(unsigned*)(KROPE + ((size_t)NP + b * SKEYS + j) * 32 + 2 * i) = pk2(src[(size_t)row * 32 + i], src[(size_t)row * 32 + 16 + i]); } }
    { const float* src = a.in(I_CLF);
      for (unsigned e = gt; e < 8u * PAST * 8; e += NT) { const unsigned row = e >> 3, h = e & 7; const unsigned b = row >> 12, j = row & 4095; LFS[(size_t)(b * SKEYS + j) * 8 + h] = src[e]; } }
}
__device__ __forceinline__ void scan_item(const float* src, float* dst, int len, LAS float* sm, int tid) {
    const int per = (len + 511) / 512, i0 = tid * per, i1 = min(len, i0 + per);
    float s = 0.f; for (int i = i0; i < i1; ++i) s += src[(size_t)i * 8];
    const int lane = tid & 63, wid = tid >> 6; float inc = s;
#pragma unroll
    for (int o = 1; o < 64; o <<= 1) { const float t = __shfl_up(inc, o); if (lane >= o) inc += t; }
    __syncthreads();
    if (lane == 63) sm[wid] = inc;
    __syncthreads();
    float pre = 0.f; for (int w = 0; w < wid; ++w) pre += sm[w];
    float run = pre + inc - s;
    for (int i = i0; i < i1; ++i) { run += src[(size_t)i * 8]; dst[(size_t)i * 8] = run; }
}

struct AttnUnit { const bf16* Q; const bf16* K; const bf16* KR; const bf16* V; const float* LK; const float* TAB; bf16* O; int qpitch, kpitch, vpitch, nkeys, qpos0, nq; };
constexpr int A_KP = 208, A_VP = 192, A_KB = 64 * A_KP, A_VB = 64 * A_VP, A_STG = A_KB + A_VB + 256, A_WS = 2 * A_STG;
__device__ __forceinline__ int crow(int r, int hi) { return (r & 3) + 8 * (r >> 2) + 4 * hi; }
typedef float f32x2_t __attribute__((ext_vector_type(2))); typedef __bf16 bf16x2_t __attribute__((ext_vector_type(2)));
__device__ __forceinline__ unsigned cvtpk(float lo, float hi) { f32x2_t v = {lo, hi}; bf16x2_t b = __builtin_convertvector(v, bf16x2_t); return __builtin_bit_cast(unsigned, b); }
#define MX3(a, b, c) __builtin_fmaxf(__builtin_fmaxf((a), (b)), (c))
template <int TYPE> __device__ __forceinline__ void attn_unit(LAS unsigned char* lds, const AttnUnit& U) {
    constexpr int ND = TYPE == 0 ? 6 : 4;
    constexpr float SC = (TYPE == 0 ? 0.10206207261596575f : 0.125f) * LOG2E;
    constexpr float THR = 40.0f;
    int tid_ = threadIdx.x; asm volatile("" : "+v"(tid_));
    const int tid = tid_, lane = tid & 63, wid = __builtin_amdgcn_readfirstlane(tid >> 6), r32 = lane & 31, hi = lane >> 5;
    const int NT = (U.qpos0 + (U.nq > 32 ? 256 : 32) - 1) / 64 + 1;
    const bool active = wid * 32 < U.nq;
    const int NTw = active ? (U.qpos0 + 32 * wid + 31) / 64 + 1 : 0;
    LAS float* wsf = (LAS float*)(lds + 6 * 20736) + wid * 64;
    constexpr int PT = 3, NSL = 2 * PT;
#define A_KS(s) ((s) * 12288)
#define A_VS(s) (NSL * 12288 + (s) * 8192)
#define A_BS(s) (NSL * 20480 + (s) * 256)
    const unsigned lds0 = (unsigned)(uintptr_t)lds;
    const int lastrow = U.nkeys - 1 - 64 * (NT - 1);
    const int lr8 = 8 * wid + (lane >> 3);
    const int kch = (lane & 7) ^ ((4 * wid + (lane >> 4)) & 7);
    const int vch = (lane & 7) ^ (((lane >> 4) & 1) * 4);
    const int rr16 = 16 * (wid & 3) + (lane >> 2), rch = (lane & 3) ^ ((lane >> 4) & 3);
    const unsigned voK = (unsigned)(lr8 * U.kpitch * 2 + 16 * kch), voKl = (unsigned)(min(lr8, lastrow) * U.kpitch * 2 + 16 * kch);
    const unsigned voV = (unsigned)(lr8 * U.vpitch * 2 + 16 * vch), voVl = (unsigned)(min(lr8, lastrow) * U.vpitch * 2 + 16 * vch);
    const unsigned voA = TYPE == 0 ? (unsigned)(rr16 * 64 + 16 * rch) : (unsigned)(lane * 32), voAl = TYPE == 0 ? (unsigned)(min(rr16, lastrow) * 64 + 16 * rch) : (unsigned)(min(lane, lastrow) * 32);
#define A_DMA16(vo, sb, dst) do { unsigned keep_; asm volatile("s_mov_b32 %0, m0\n\ts_mov_b32 m0, %3\n\ts_nop 0\n\tglobal_load_lds_dwordx4 %1, %2\n\ts_mov_b32 m0, %0" : "=&s"(keep_) : "v"(vo), "s"(sb), "s"(dst) : "memory"); } while (0)
#define A_DMA4(vo, sb, dst) do { unsigned keep_; asm volatile("s_mov_b32 %0, m0\n\ts_mov_b32 m0, %3\n\ts_nop 0\n\tglobal_load_lds_dword %1, %2\n\ts_mov_b32 m0, %0" : "=&s"(keep_) : "v"(vo), "s"(sb), "s"(dst) : "memory"); } while (0)
#define A_DMAK(t, slot) do { const int tc_ = min((int)(t), NT - 1); const bool l_ = tc_ == NT - 1; \
        const bf16* kb_ = U.K + (size_t)(64 * tc_) * U.kpitch; \
        A_DMA16(l_ ? voKl : voK, kb_, (unsigned)__builtin_amdgcn_readfirstlane(lds0 + A_KS(slot) + wid * 1024)); \
        if (TYPE == 0) { const bf16* rb_ = U.KR + (size_t)(64 * tc_) * 32; A_DMA16(l_ ? voAl : voA, rb_, (unsigned)__builtin_amdgcn_readfirstlane(lds0 + A_KS(slot) + 8192 + (wid & 3) * 1024)); } \
        else { const float* bb_ = U.LK + (size_t)(64 * tc_) * 8; A_DMA4(l_ ? voAl : voA, bb_, (unsigned)__builtin_amdgcn_readfirstlane(lds0 + A_BS(slot))); } } while (0)
#define A_DMAV(t, slot) do { const int tc_ = min((int)(t), NT - 1); const bool l_ = tc_ == NT - 1; const bf16* vb_ = U.V + (size_t)(64 * tc_) * U.vpitch; \
        A_DMA16(l_ ? voVl : voV, vb_, (unsigned)__builtin_amdgcn_readfirstlane(lds0 + A_VS(slot) + wid * 1024)); } while (0)
#define A_SB() __builtin_amdgcn_sched_barrier(0)
#define A_PINW() asm volatile("" : "+v"(pw[0]), "+v"(pw[1]), "+v"(pw[2]), "+v"(pw[3]))
#define A_PINP() asm volatile("" : "+v"(p0), "+v"(p1))
#define A_PK1(c) do { if ((c) < 16) { const int i_ = 2 * (c); pw[(c) >> 2][(c) & 3] = cvtpk(i_ < 16 ? p0[i_ & 15] : p1[i_ & 15], i_ < 16 ? p0[(i_ + 1) & 15] : p1[(i_ + 1) & 15]); } } while (0)
    unsigned kad[ND];
#pragma unroll
    for (int d0 = 0; d0 < ND; ++d0) kad[d0] = lds0 + (d0 < 4 ? r32 * 128 + 16 * ((2 * d0 + hi) ^ ((r32 >> 1) & 7)) : 8192 + r32 * 64 + 16 * ((2 * (d0 - 4) + hi) ^ ((r32 >> 2) & 3)));
    const int vq_ = (lane & 15) >> 2, vp_ = lane & 3, vsw_ = ((vq_ >> 1) & 1) * 4, vck_ = 2 * ((lane >> 4) & 1) + (vp_ >> 1);
    const unsigned vad0 = lds0 + (4 * hi + vq_) * 128 + 16 * (vck_ ^ vsw_) + 8 * (vp_ & 1), vad1 = lds0 + (4 * hi + vq_) * 128 + 16 * ((4 + vck_) ^ vsw_) + 8 * (vp_ & 1);
    const unsigned bad = lds0 + 16 * hi;
#define A_LDK(d0, half) (*(const LAS bf16x8*)(uintptr_t)(kcur[d0] + (half) * ((d0) < 4 ? 32 * 128 : 32 * 64)))
#define A_QKPRE(SK, s0, s1) \
        unsigned kcur[ND]; \
        _Pragma("unroll") for (int d0 = 0; d0 < ND; ++d0) kcur[d0] = kad[d0] + (unsigned)A_KS(SK); \
        if (TYPE == 1) { const float nm_ = -mref; const unsigned bcur = bad + (unsigned)A_BS(SK); \
            _Pragma("unroll") for (int g = 0; g < 4; ++g) { const f32x4 b0 = *(const LAS f32x4*)(uintptr_t)(bcur + 32 * g), b1 = *(const LAS f32x4*)(uintptr_t)(bcur + 128 + 32 * g); \
                _Pragma("unroll") for (int i = 0; i < 4; ++i) { s0[4 * g + i] = __builtin_fmaf(b0[i], -LOG2E, nm_); s1[4 * g + i] = __builtin_fmaf(b1[i], -LOG2E, nm_); } } \
        } else { s0 = negm; s1 = negm; } \
        bf16x8 ka0 = A_LDK(0, 0), ka1 = A_LDK(0, 1);
#define A_QK(SK, s0, s1, PACK) do { \
        A_SB(); \
        _Pragma("unroll") for (int d0 = 0; d0 < ND; ++d0) { \
            bf16x8 kn0 = ka0, kn1 = ka1; \
            if (d0 + 1 < ND) { kn0 = A_LDK((d0 + 1 < ND ? d0 + 1 : 0), 0); kn1 = A_LDK((d0 + 1 < ND ? d0 + 1 : 0), 1); } \
            s0 = __builtin_amdgcn_mfma_f32_32x32x16_bf16(ka0, qf[d0], s0, 0, 0, 0); \
            if (PACK) { A_PK1(4 * d0); A_PK1(4 * d0 + 1); A_PINW(); } \
            A_SB(); \
            s1 = __builtin_amdgcn_mfma_f32_32x32x16_bf16(ka1, qf[d0], s1, 0, 0, 0); \
            if (PACK) { A_PK1(4 * d0 + 2); A_PK1(4 * d0 + 3); A_PINW(); } \
            A_SB(); \
            ka0 = kn0; ka1 = kn1; } } while (0)
#define A_PACK() do { _Pragma("unroll") for (int c = 0; c < 16; ++c) A_PK1(c); } while (0)
#define A_MASK(t, s0, s1) do { const int qpos = U.qpos0 + 32 * wid + r32; \
        _Pragma("unroll") for (int r = 0; r < 16; ++r) { const int kv = 64 * (t) + crow(r, hi); \
            if (!(kv < U.nkeys && (TYPE == 0 || kv <= qpos))) s0[r] = -INFINITY; \
            if (!(kv + 32 < U.nkeys && (TYPE == 0 || kv + 32 <= qpos))) s1[r] = -INFINITY; } } while (0)
#define A_ROWMAX(s0, s1, mt) do { float ma = MX3(s0[0], s0[1], s1[0]), mb = MX3(s0[2], s0[3], s1[1]); ma = MX3(ma, s1[2], s1[3]); \
        _Pragma("unroll") for (int r = 4; r < 16; r += 4) { ma = MX3(ma, s0[r], s0[r + 1]); mb = MX3(mb, s0[r + 2], s0[r + 3]); ma = MX3(ma, s1[r], s1[r + 1]); mb = MX3(mb, s1[r + 2], s1[r + 3]); } \
        mt = fmaxf(ma, mb); { const auto rr_ = __builtin_amdgcn_permlane32_swap(__float_as_uint(mt), __float_as_uint(mt), false, false); mt = fmaxf(__uint_as_float(rr_[0]), __uint_as_float(rr_[1])); } } while (0)
#define A_TR(a) __builtin_bit_cast(s16x4, __builtin_amdgcn_ds_read_tr16_b64_v4i16((LAS s16x4*)(uintptr_t)(a)))
#define A_VRD(dst0, dst1, kk_, SV) do { const int kvb_ = 32 * ((kk_) >> 1) + 16 * ((kk_) & 1); \
        const s16x4 l0_ = A_TR(vcur0 + kvb_ * 128), h0_ = A_TR(vcur0 + (kvb_ + 8) * 128), l1_ = A_TR(vcur1 + kvb_ * 128), h1_ = A_TR(vcur1 + (kvb_ + 8) * 128); \
        dst0 = (bf16x8){l0_[0], l0_[1], l0_[2], l0_[3], h0_[0], h0_[1], h0_[2], h0_[3]}; dst1 = (bf16x8){l1_[0], l1_[1], l1_[2], l1_[3], h1_[0], h1_[1], h1_[2], h1_[3]}; } while (0)
#define A_EX0(r, sv) p0[r] = __builtin_amdgcn_exp2f(sv[r])
#define A_EX1(r, sv) p1[r] = __builtin_amdgcn_exp2f(sv[r])
#define A_PV(SV, EXPS, s0, s1) do { \
        const unsigned vcur0 = vad0 + (unsigned)A_VS(SV), vcur1 = vad1 + (unsigned)A_VS(SV); \
        bf16x8 va0, va1; A_VRD(va0, va1, 0, SV); \
        A_SB(); \
        _Pragma("unroll") for (int kk = 0; kk < 4; ++kk) { \
            const bf16x8 pk_ = __builtin_bit_cast(bf16x8, pw[kk]); \
            bf16x8 vn0 = va0, vn1 = va1; \
            o2 = __builtin_amdgcn_mfma_f32_32x32x16_bf16(pk_, ones, o2, 0, 0, 0); \
            if (EXPS) { A_EX0(4 * kk, s0); A_EX0(4 * kk + 1, s0); A_EX1(4 * kk, s1); A_PINP(); } \
            if (kk + 1 < 4) A_VRD(vn0, vn1, kk + 1, SV); \
            A_SB(); \
            o0 = __builtin_amdgcn_mfma_f32_32x32x16_bf16(pk_, va0, o0, 0, 0, 0); \
            if (EXPS) { A_EX0(4 * kk + 2, s0); A_EX1(4 * kk + 1, s1); A_EX1(4 * kk + 2, s1); A_PINP(); } \
            A_SB(); \
            o1 = __builtin_amdgcn_mfma_f32_32x32x16_bf16(pk_, va1, o1, 0, 0, 0); \
            if (EXPS) { A_EX0(4 * kk + 3, s0); A_EX1(4 * kk + 3, s1); A_PINP(); } \
            A_SB(); \
            va0 = vn0; va1 = vn1; } } while (0)
    float mref = 0.f;
    f32x16 o0 = {}, o1 = {}, o2 = {}, negm = {}, p0 = {}, p1 = {};
    u32x4 pw[4] = {};
    const bf16x8 ones = {0x3F80, 0x3F80, 0x3F80, 0x3F80, 0x3F80, 0x3F80, 0x3F80, 0x3F80};
#define A_WAITBAR(n) asm volatile("s_waitcnt vmcnt(" #n ") lgkmcnt(0)\n\ts_barrier" ::: "memory")
#pragma unroll
    for (int k = 0; k < PT; ++k) { A_DMAK(k, k); if (k + 1 < PT) A_DMAV(k, k); }
    bf16x8 qf[ND];
    { int qrow = wid * 32 + r32; if (qrow >= U.nq) qrow = U.nq - 1;
      const bf16* qp = U.Q + (size_t)qrow * U.qpitch + hi * 8;
#pragma unroll
      for (int d0 = 0; d0 < ND; ++d0) qf[d0] = *(const GAS bf16x8*)(qp + d0 * 16);
#pragma unroll
      for (int d0 = 0; d0 < ND; ++d0) {
          u32x4 w = __builtin_bit_cast(u32x4, qf[d0]);
          if (TYPE == 0 && d0 >= 4) {
              const float* tb = U.TAB + (size_t)(U.qpos0 + qrow) * 32; const int pb = 8 * (d0 - 4) + 4 * hi; const f32x4 t0 = *(const GAS f32x4*)(tb + 2 * pb), t1 = *(const GAS f32x4*)(tb + 2 * pb + 4);
              { const float x1 = bflo(w.x), x2 = bfhi(w.x); w.x = cvtpk((x1 * t0[0] - x2 * t0[1]) * SC, (x1 * t0[1] + x2 * t0[0]) * SC); }
              { const float x1 = bflo(w.y), x2 = bfhi(w.y); w.y = cvtpk((x1 * t0[2] - x2 * t0[3]) * SC, (x1 * t0[3] + x2 * t0[2]) * SC); }
              { const float x1 = bflo(w.z), x2 = bfhi(w.z); w.z = cvtpk((x1 * t1[0] - x2 * t1[1]) * SC, (x1 * t1[1] + x2 * t1[0]) * SC); }
              { const float x1 = bflo(w.w), x2 = bfhi(w.w); w.w = cvtpk((x1 * t1[2] - x2 * t1[3]) * SC, (x1 * t1[3] + x2 * t1[2]) * SC); }
          } else { w.x = cvtpk(bflo(w.x) * SC, bfhi(w.x) * SC); w.y = cvtpk(bflo(w.y) * SC, bfhi(w.y) * SC); w.z = cvtpk(bflo(w.z) * SC, bfhi(w.z) * SC); w.w = cvtpk(bflo(w.w) * SC, bfhi(w.w) * SC); }
          qf[d0] = __builtin_bit_cast(bf16x8, w); } }
    A_WAITBAR(0);
#define A_SLOT(k) ((sk + (k)) >= NSL ? (sk + (k)) - NSL : (sk + (k)))
#define A_TOP(t, d1_, d2_) do { A_DMAK((t) + PT, A_SLOT(PT)); A_DMAV((t) + PT - 1, A_SLOT(PT - 1)); } while (0)
#define A_BOT() do { if (ph == PT - 1) { A_WAITBAR(0); } } while (0)
    int t = 0, sk = 0, sk2 = NSL - 1, ph = 0;
    const int sk1 = 0; (void)sk1;
#define A_ROT() do { sk2 = sk; sk = (sk + 1 == NSL) ? 0 : sk + 1; ph = (ph + 1 == PT) ? 0 : ph + 1; } while (0)
    {
        if (NTw > 0) {
            f32x16 s0, s1;
            A_QKPRE(sk, s0, s1)
            A_TOP(0, sk2, sk1);
            A_QK(sk, s0, s1, false);
            if (NTw == 1) A_MASK(0, s0, s1);
            float mt; A_ROWMAX(s0, s1, mt);
            mref = mt;
#pragma unroll
            for (int r = 0; r < 16; ++r) { if (TYPE == 0) negm[r] = -mref; p0[r] = __builtin_amdgcn_exp2f(s0[r] - mt); p1[r] = __builtin_amdgcn_exp2f(s1[r] - mt); }
        } else { A_TOP(0, sk2, sk1); }
        A_BOT(); A_ROT();
    }
    for (t = 1; t < NTw; ++t) {
        f32x16 s0, s1;
        A_QKPRE(sk, s0, s1)
        A_TOP(t, sk2, sk1);
        A_QK(sk, s0, s1, true);
        if (t == NTw - 1) A_MASK(t, s0, s1);
        float mt; A_ROWMAX(s0, s1, mt);
        bool resc = false;
        if (__any(mt > THR)) {
            const float dl = fmaxf(mt, 0.f); mref += dl;
#pragma unroll
            for (int r = 0; r < 16; ++r) { s0[r] -= dl; s1[r] -= dl; if (TYPE == 0) negm[r] = -mref; }
            if (hi == 0) wsf[r32] = __builtin_amdgcn_exp2f(-dl);
            resc = true;
        }
        A_PV(sk2, true, s0, s1);
        if (resc) {
            asm volatile("s_waitcnt lgkmcnt(0)" ::: "memory");
#pragma unroll
            for (int g = 0; g < 4; ++g) { const f32x4 al = *(const LAS f32x4*)(wsf + 8 * g + 4 * hi);
#pragma unroll
                for (int i = 0; i < 4; ++i) { o0[4 * g + i] *= al[i]; o1[4 * g + i] *= al[i]; o2[4 * g + i] *= al[i]; } }
            asm volatile("s_waitcnt lgkmcnt(0)" ::: "memory");
        }
        A_BOT(); A_ROT();
    }
    if (NTw > 0) {
        A_TOP(t, sk2, sk1);
        A_PACK();
        A_PV(sk2, false, p0, p1);
        A_BOT(); A_ROT();
        ++t;
    }
    for (; t <= NT; ++t) { A_TOP(t, sk2, sk1); A_BOT(); A_ROT(); }
    asm volatile("s_waitcnt vmcnt(0)" ::: "memory");
    if (active) {
#pragma unroll
        for (int r = 0; r < 16; ++r) { const int q = wid * 32 + crow(r, hi);
            if (q < U.nq) { const float il = __builtin_amdgcn_rcpf(o2[r]); GAS bf16* op = (GAS bf16*)(U.O + (size_t)q * DM + r32); op[0] = (bf16)f2bf(o0[r] * il); op[32] = (bf16)f2bf(o1[r] * il); } }
    }
    __syncthreads();
#undef A_KS
#undef A_VS
#undef A_BS
#undef A_DMA16
#undef A_DMA4
#undef A_DMAK
#undef A_DMAV
#undef A_SB
#undef A_PINW
#undef A_PINP
#undef A_PK1
#undef A_LDK
#undef A_QKPRE
#undef A_QK
#undef A_PACK
#undef A_MASK
#undef A_ROWMAX
#undef A_TR
#undef A_VRD
#undef A_EX0
#undef A_EX1
#undef A_PV
#undef A_WAITBAR
#undef A_TOP
#undef A_BOT
#undef A_ROT
#undef A_SLOT
}
__device__ __forceinline__ void attn_phase(const Ctx& a, LAS unsigned char* lds) {
    unsigned char* ws = a.ws();
    const bf16* PROJ = (const bf16*)(ws + WS_PROJ); const bf16* QM = (const bf16*)(ws + WS_QM); const bf16* KV = (const bf16*)(ws + WS_KV); const bf16* KROPE = (const bf16*)(ws + WS_KROPE);
    const bf16* FKS = (const bf16*)(ws + WS_FKS); const bf16* FVS = (const bf16*)(ws + WS_FVS); const float* LKB = (const float*)(ws + WS_LK); bf16* OB = (bf16*)(ws + WS_XN);
    unsigned* qctr = (unsigned*)(ws + WS_QCTR);
    const int myx = (int)(__builtin_amdgcn_s_getreg((3 << 11) | 20) & 7u);
    LAS int* slot = (LAS int*)(lds + PTR_OFF + 256);
    int qoff = 0;
    for (;;) {
        if (threadIdx.x == 0) {
            int e = -1, x = 0;
            while (qoff < 8) { x = (myx + qoff) & 7; const unsigned v = atomicAdd(qctr + 64 * x, 1u); if (v < 272u) { e = (int)v; break; } ++qoff; }
            slot[0] = e; slot[1] = x;
        }
        __syncthreads();
        const int e = slot[0], x = slot[1];
        __syncthreads();
        if (e < 0) break;
        const int nhalf = e < 256 ? 2 : 1;
        for (int half = 0; half < nhalf; ++half) {
            AttnUnit U; int type; U.TAB = (const float*)(ws + WS_TAB);
            if (e < 256) {
                const int ks = e >> 4, jj = e & 15;
                const int s = x + 8 * ks; type = s >> 6; const int b = (s >> 3) & 7, h = s & 7, qb = half ? 31 - jj : jj; const size_t r0 = (size_t)b * SEQ, q0 = r0 + 256 * qb;
                U.nkeys = SEQ; U.qpos0 = 256 * qb; U.nq = 256;
                if (type == 0) { U.Q = QM + q0 * NQ + 96 * h; U.qpitch = NQ; U.K = KV + r0 * NKV + 128 * h; U.kpitch = NKV; U.KR = KROPE + r0 * 32; U.V = KV + r0 * NKV + 128 * h + 64; U.vpitch = NKV; U.LK = nullptr; U.O = OB + q0 * DM + 64 * h; }
                else { U.Q = PROJ + q0 * NINP + C_FQ + 64 * h; U.qpitch = NINP; U.K = PROJ + r0 * NINP + C_FK + 64 * h; U.kpitch = NINP; U.KR = nullptr; U.V = PROJ + r0 * NINP + C_FV + 64 * h; U.vpitch = NINP; U.LK = LKB + r0 * 8 + h; U.O = OB + q0 * DM + 512 + 64 * h; }
            } else {
                const int j = e - 256; type = j >> 3; const int b = j & 7, h = x; const size_t q0 = (size_t)NP + 16 * b, r0 = (size_t)NP + (size_t)b * SKEYS;
                U.nkeys = SKEYS; U.qpos0 = PAST; U.nq = DSEQ;
                if (type == 0) { U.Q = QM + q0 * NQ + 96 * h; U.qpitch = NQ; U.K = KV + r0 * NKV + 128 * h; U.kpitch = NKV; U.KR = KROPE + r0 * 32; U.V = KV + r0 * NKV + 128 * h + 64; U.vpitch = NKV; U.LK = nullptr; U.O = OB + q0 * DM + 64 * h; }
                else { U.Q = PROJ + q0 * NINP + C_FQ + 64 * h; U.qpitch = NINP; U.K = FKS + (size_t)b * SKEYS * 512 + 64 * h; U.kpitch = 512; U.KR = nullptr; U.V = FVS + (size_t)b * SKEYS * 512 + 64 * h; U.vpitch = 512; U.LK = LKB + r0 * 8 + h; U.O = OB + q0 * DM + 512 + 64 * h; }
            }
            if (type == 0) attn_unit<0>(lds, U); else attn_unit<1>(lds, U);
        }
    }
}

template <class Epi> __device__ __forceinline__ void run_gemm(LAS unsigned char* lds, const bf16* A, const bf16* Bt, int M, int N, int K, const Epi& E) {
    pg8::Gemm g{A, Bt, M, N, K}; pg8::StaticOrder S; S.init(M, N, (int)gridDim.x, (int)blockIdx.x);
    pg8::gemm_phase<Epi, pg8::StaticOrder, true, true>(lds, g, S, E);
}
#define XB_TMO      128
#define XB_XCNT(j)  (256  + 64 * (j))
#define XB_XSUB(j)  (1280 + 64 * (j))
#define XB_XGEN(j)  (2304 + 64 * (j))
#define XB_TOP      3328
#define XB_TOPGEN   3392
#define XCD_BAR_WORDS 3456
#define XB_SPIN_CAP (1u << 18)

__device__ __forceinline__ unsigned xb_ld(unsigned* p)              { return __hip_atomic_load(p, __ATOMIC_RELAXED, __HIP_MEMORY_SCOPE_AGENT); }
__device__ __forceinline__ unsigned xb_add(unsigned* p, unsigned v) { return __hip_atomic_fetch_add(p, v, __ATOMIC_RELAXED, __HIP_MEMORY_SCOPE_AGENT); }
__device__ __forceinline__ unsigned xb_xcc_id() { return (unsigned)__builtin_amdgcn_s_getreg((3 << 11) | 20) & 0xFu; }
#define XB_SPIN(cond, bar) do { unsigned _sp = 0; while (cond) { __builtin_amdgcn_s_sleep(1); \
    if ((++_sp & 255u) == 0u) { if (xb_ld(&(bar)[XB_TMO])) break; if (_sp > XB_SPIN_CAP) { atomicAdd(&(bar)[XB_TMO], 1u); break; } } } } while (0)

struct XcdBarrier {
    unsigned* bar; unsigned x;
    volatile LAS unsigned* st;
};

__device__ __forceinline__ XcdBarrier xcd_barrier_post(unsigned* bar, volatile LAS unsigned* st) {
    XcdBarrier b; b.bar = bar; b.x = xb_xcc_id(); b.st = st;
    if (threadIdx.x == 0) (void)xb_add(&bar[XB_XCNT(b.x)], 1u);
    return b;
}
__device__ __forceinline__ void xcd_barrier_complete(unsigned* bar, unsigned x, unsigned& nloc, unsigned& nx) {
    const unsigned G = gridDim.x * gridDim.y * gridDim.z;
    unsigned sum, cnt, mine, sp = 0u;
    for (;;) {
        sum = 0u; cnt = 0u; mine = 0u;
#pragma unroll
        for (unsigned j = 0; j < 16; ++j) { const unsigned c = xb_ld(&bar[XB_XCNT(j)]); sum += c; cnt += (c > 0u) ? 1u : 0u; mine = (j == x) ? c : mine; }
        if (sum == G) break;
        __builtin_amdgcn_s_sleep(1);
        if ((++sp & 255u) == 0u) { if (xb_ld(&bar[XB_TMO])) break; if (sp > XB_SPIN_CAP) { atomicAdd(&bar[XB_TMO], 1u); break; } }
    }
    nloc = mine > 0u ? mine : 1u; nx = cnt > 0u ? cnt : 1u;
}

__device__ __forceinline__ void xcd_barrier(const XcdBarrier& b) {
    asm volatile("s_waitcnt vmcnt(0)" ::: "memory");
    __syncthreads();
    if (threadIdx.x == 0) {
        unsigned* bar = b.bar;
        __builtin_amdgcn_s_waitcnt(0);
        unsigned nloc = b.st[0], nx = b.st[1];
        if (nloc == 0u) { xcd_barrier_complete(bar, b.x, nloc, nx); b.st[0] = nloc; b.st[1] = nx; }
        const unsigned old = xb_add(&bar[XB_XSUB(b.x)], 1u);
        const unsigned gen = old / nloc;
        if (old + 1u == (gen + 1u) * nloc) {
            __builtin_amdgcn_fence(__ATOMIC_RELEASE, "agent");
            asm volatile("s_waitcnt vmcnt(0)" ::: "memory");
            const unsigned og = xb_add(&bar[XB_TOP], 1u);
            const unsigned tg = og / nx;
            if (og + 1u == (tg + 1u) * nx) xb_add(&bar[XB_TOPGEN], 1u);
            else XB_SPIN(xb_ld(&bar[XB_TOPGEN]) == tg, bar);
            __builtin_amdgcn_fence(__ATOMIC_ACQUIRE, "agent");
            xb_add(&bar[XB_XGEN(b.x)], 1u);
            asm volatile("s_waitcnt vmcnt(0)" ::: "memory");
        } else {
            XB_SPIN(xb_ld(&bar[XB_XGEN(b.x)]) == gen, bar);
            __builtin_amdgcn_fence(__ATOMIC_ACQUIRE, "agent");
            asm volatile("s_waitcnt vmcnt(0)" ::: "memory");
        }
    }
    __syncthreads();
}

__device__ __forceinline__ void blk_signal(unsigned* flag) { __threadfence(); __syncthreads(); if (threadIdx.x == 0) __hip_atomic_fetch_add(flag, 1u, __ATOMIC_RELEASE, __HIP_MEMORY_SCOPE_AGENT); }
__device__ __forceinline__ void blk_wait(unsigned* flag, unsigned n) {
    if (threadIdx.x == 0) { while (__hip_atomic_load(flag, __ATOMIC_ACQUIRE, __HIP_MEMORY_SCOPE_AGENT) < n) __builtin_amdgcn_s_sleep(8); }
    __syncthreads(); __threadfence();
}
__global__ void __launch_bounds__(512, 2) mega_fwd(Args a) {
    extern __shared__ __attribute__((aligned(16))) unsigned char lds_raw[];
    LAS unsigned char* lds = (LAS unsigned char*)lds_raw;
    cg::grid_group grid = cg::this_grid();
#define PH_IDS() int tid_l_ = threadIdx.x; asm volatile("" : "+v"(tid_l_)); const int tid = tid_l_, lane = tid & 63, wave = __builtin_amdgcn_readfirstlane(tid >> 6), gw = blockIdx.x * 8 + wave, NGW = gridDim.x * 8; (void)tid; (void)lane; (void)wave; (void)gw; (void)NGW
    { const unsigned long long* ka = (const unsigned long long*)__builtin_amdgcn_kernarg_segment_ptr(); const int tid = threadIdx.x;
      if (tid < 26) *(LAS unsigned long long*)(lds + PTR_OFF + 8 * tid) = ka[tid];
      if (tid < 2) *(LAS unsigned*)(lds + PTR_OFF + 512 + 4 * tid) = 0u; }
    __syncthreads();
    const Ctx c{lds};
#define WSP(T, off) ((T*)(c.ws() + (off)))
    { PH_IDS(); LAS float* scr = (LAS float*)(lds + wave * 16384);
      transpose_w(c.in(I_W1GU), DM, NGU, WSP(bf16, WS_WGU1), NGU, MapGU(), scr, gw, NGW, lane);
      transpose_w(c.in(I_W1D), DFF, DM, WSP(bf16, WS_WD1), DM, MapId(), scr, gw, NGW, lane);
      transpose_w(c.in(I_W2GU), DM, NGU, WSP(bf16, WS_WGU2), NGU, MapGU(), scr, gw, NGW, lane);
      transpose_w(c.in(I_W2D), DFF, DM, WSP(bf16, WS_WD2), DM, MapId(), scr, gw, NGW, lane);
      transpose_w(c.in(I_WIN), DM, NIN, WSP(bf16, WS_WIN), NINP, MapIn(), scr, gw, NGW, lane);
      transpose_w(c.in(I_WQ), QLORA, NQ, WSP(bf16, WS_WQ), NQ, MapQ(), scr, gw, NGW, lane);
      transpose_w(c.in(I_WKV), KVLORA, NKV, WSP(bf16, WS_WKV), NKV, MapId(), scr, gw, NGW, lane);
      transpose_w(c.in(I_WO), DM, DM, WSP(bf16, WS_WO), DM, MapId(), scr, gw, NGW, lane);
      { float* TAB = WSP(float, WS_TAB); for (int e = gw * 64 + lane; e < SEQ * 16; e += NGW * 64) { float cc, ss; rope_cs(e >> 4, e & 15, cc, ss); TAB[2 * e] = cc; TAB[2 * e + 1] = ss; } }
      if (blockIdx.x == 0 && tid < 16) WSP(unsigned, WS_QCTR)[64 * tid] = 0u;
      if (blockIdx.x == 1) { for (int w = tid; w < XCD_BAR_WORDS; w += 512) WSP(unsigned, WS_BAR)[w] = 0u; }
      rp_norm_only(c, c.in(I_G1PRE), WSP(bf16, WS_XN), gw, NGW, lane); }
    grid.sync();
    const XcdBarrier xbar = xcd_barrier_post(WSP(unsigned, WS_BAR), (volatile LAS unsigned*)(lds + PTR_OFF + 512));
#define GSYNC() xcd_barrier(xbar)
#define FLAG(i) (WSP(unsigned, WS_QCTR) + 512 + 64 * (i))
#define SROW(T, off, ld) (WSP(T, off) + (size_t)NP * (ld))
    run_gemm(lds, WSP(bf16, WS_XN), WSP(bf16, WS_WGU1), MPAD, NGU, DM, pg8::EpiSwiGLU{WSP(bf16, WS_ACT), DFF});
    GSYNC();
    run_gemm(lds, WSP(bf16, WS_ACT), WSP(bf16, WS_WD1), NP, DM, DFF, pg8::EpiStore{WSP(bf16, WS_D), DM});
    GSYNC();
    if (blockIdx.x < 4) {
        run_gemm(lds, SROW(bf16, WS_ACT, DFF), WSP(bf16, WS_WD1), 256, DM, DFF, pg8::EpiStore{SROW(bf16, WS_D, DM), DM}); blk_signal(FLAG(1));
        { blk_wait(FLAG(1), 4); PH_IDS(); rp_residual(c, true, false, WSP(bf16, WS_D), 0.5f, c.in(I_G1POST), c.in(I_GMPRE), c.out(), WSP(bf16, WS_XN), NP, NTOK, gw, 4 * 8, lane); }
    } else { PH_IDS(); rp_residual(c, true, false, WSP(bf16, WS_D), 0.5f, c.in(I_G1POST), c.in(I_GMPRE), c.out(), WSP(bf16, WS_XN), 0, NP, gw - 4 * 8, NGW - 4 * 8, lane);
    }
    GSYNC();
    run_gemm(lds, WSP(bf16, WS_XN), WSP(bf16, WS_WIN), NP, NINP, DM, pg8::EpiStore{WSP(bf16, WS_PROJ), NINP});
    GSYNC();
    if (blockIdx.x < 9) {
        run_gemm(lds, SROW(bf16, WS_XN, DM), WSP(bf16, WS_WIN), 256, NINP, DM, pg8::EpiStore{SROW(bf16, WS_PROJ, NINP), NINP});
        blk_signal(FLAG(2));
        { blk_wait(FLAG(2), 9); PH_IDS(); rp_mix(c, NP, NTOK, false, gw, 9 * 8, lane); }
    } else { PH_IDS(); rp_mix(c, 0, NP, true, gw - 9 * 8, NGW - 9 * 8, lane); }
    GSYNC();
    run_gemm(lds, WSP(bf16, WS_CQN), WSP(bf16, WS_WQ), MPAD, NQ, QLORA, pg8::EpiStore{WSP(bf16, WS_QM), NQ});
    run_gemm(lds, WSP(bf16, WS_CKVN), WSP(bf16, WS_WKV), KPAD, NKV, KVLORA, pg8::EpiStore{WSP(bf16, WS_KV), NKV});
    for (int i = blockIdx.x; i < 128; i += gridDim.x) {
        PH_IDS(); const int b = (i >> 3) & 7, h = i & 7;
        if (i < 64) scan_item(c.out() + O_LFP + (size_t)b * SEQ * 8 + h, WSP(float, WS_LK) + (size_t)b * SEQ * 8 + h, SEQ, (LAS float*)lds, tid);
        else scan_item(WSP(float, WS_LFS) + (size_t)b * SKEYS * 8 + h, WSP(float, WS_LK) + ((size_t)NP + (size_t)b * SKEYS) * 8 + h, SKEYS, (LAS float*)lds, tid);
        __syncthreads();
    }
    GSYNC();
    attn_phase(c, lds);
    GSYNC();
    run_gemm(lds, WSP(bf16, WS_XN), WSP(bf16, WS_WO), NP, DM, DM, pg8::EpiStore{WSP(bf16, WS_D), DM});
    GSYNC();
    if (blockIdx.x < 4) {
        run_gemm(lds, SROW(bf16, WS_XN, DM), WSP(bf16, WS_WO), 256, DM, DM, pg8::EpiStore{SROW(bf16, WS_D, DM), DM});
        blk_signal(FLAG(3));
        { blk_wait(FLAG(3), 4); PH_IDS(); rp_residual(c, false, false, WSP(bf16, WS_D), 1.0f, c.in(I_GMPOST), c.in(I_G2PRE), c.out(), WSP(bf16, WS_XN), NP, NTOK, gw, 4 * 8, lane); }
    } else { PH_IDS(); rp_residual(c, false, false, WSP(bf16, WS_D), 1.0f, c.in(I_GMPOST), c.in(I_G2PRE), c.out(), WSP(bf16, WS_XN), 0, NP, gw - 4 * 8, NGW - 4 * 8, lane);
    }
    GSYNC();
    run_gemm(lds, WSP(bf16, WS_XN), WSP(bf16, WS_WGU2), MPAD, NGU, DM, pg8::EpiSwiGLU{WSP(bf16, WS_ACT), DFF});
    GSYNC();
    run_gemm(lds, WSP(bf16, WS_ACT), WSP(bf16, WS_WD2), NP, DM, DFF, pg8::EpiStore{WSP(bf16, WS_D), DM});
    GSYNC();
    if (blockIdx.x < 4) {
        run_gemm(lds, SROW(bf16, WS_ACT, DFF), WSP(bf16, WS_WD2), 256, DM, DFF, pg8::EpiStore{SROW(bf16, WS_D, DM), DM}); blk_signal(FLAG(5));
        { blk_wait(FLAG(5), 4); PH_IDS(); rp_residual(c, false, true, WSP(bf16, WS_D), 0.5f, c.in(I_G2POST), nullptr, c.out(), WSP(bf16, WS_XN), NP, NTOK, gw, 4 * 8, lane); }
    } else { PH_IDS(); rp_residual(c, false, true, WSP(bf16, WS_D), 0.5f, c.in(I_G2POST), nullptr, c.out(), WSP(bf16, WS_XN), 0, NP, gw - 4 * 8, NGW - 4 * 8, lane);
    }
#undef FLAG
#undef SROW
#undef WSP
#undef PH_IDS
#undef GSYNC
}

extern "C" void kernel_launch(void* const* d_in, const int* in_sizes, int n_in, void* d_out, int out_size, void* d_ws, size_t ws_size, hipStream_t stream) {
    static int grid_blocks = 0;
    if (grid_blocks == 0) {
        if (n_in != 24 || (size_t)out_size != O_END || ws_size < WS_END) { fprintf(stderr, "kernel_launch: unexpected shapes: n_in %d out %d ws %zu (need %zu)\n", n_in, out_size, ws_size, (size_t)WS_END); grid_blocks = -1; return; }
        int dev = 0, cus = 0, per_cu = 0;
        hipGetDevice(&dev); hipDeviceGetAttribute(&cus, hipDeviceAttributeMultiprocessorCount, dev);
        if (hipFuncSetAttribute((const void*)mega_fwd, hipFuncAttributeMaxDynamicSharedMemorySize, LDS_BYTES) != hipSuccess) { fprintf(stderr, "kernel_launch: hipFuncSetAttribute failed\n"); grid_blocks = -1; return; }
        if (hipOccupancyMaxActiveBlocksPerMultiprocessor(&per_cu, (const void*)mega_fwd, 512, LDS_BYTES) != hipSuccess || per_cu < 1) { fprintf(stderr, "kernel_launch: occupancy query says %d\n", per_cu); per_cu = 1; (void)hipGetLastError(); }
        grid_blocks = cus * per_cu;
    }
    if (grid_blocks < 0) return;
    Args a{};
    for (int i = 0; i < 24; ++i) a.in[i] = (const float*)d_in[i];
    a.out = (float*)d_out; a.ws = (unsigned char*)d_ws;
    void* args[] = {&a};
    hipError_t e = hipLaunchCooperativeKernel((const void*)mega_fwd, dim3(grid_blocks), dim3(512), args, LDS_BYTES, stream);
    if (e != hipSuccess) fprintf(stderr, "cooperative launch failed: %s (grid %d)\n", hipGetErrorString(e), grid_blocks);
}
```

```cpp
#include <hip/hip_runtime.h>
#include <hip/hip_cooperative_groups.h>
#include <cstdio>
#include <cstdint>
namespace cg = cooperative_groups;
namespace pg8 {
#define PG8_LAS __attribute__((address_space(3)))
typedef unsigned short bf16_t;
typedef short bf16x8 __attribute__((ext_vector_type(8)));
typedef float f32x4 __attribute__((ext_vector_type(4)));
typedef unsigned u32x4 __attribute__((ext_vector_type(4)));
constexpr int BM = 256, BK = 64, HALF = 128, HTB = HALF * BK * 2  , STAGE_BYTES = 8 * HTB, NXCD = 8, WGM = 8;

__host__ __device__ __forceinline__ int lds_byte(int r, int c) { const int st = (r >> 4) * 2 + (c >> 5), rr = r & 15, cc = c & 31, ob = rr * 64 + cc * 2; return st * 1024 + (ob ^ (((ob >> 9) & 1) << 5)); }
__host__ __device__ __forceinline__ void stage_rc(int b, int& R, int& C) { const int st = b / 1024, sb = b % 1024, swz = sb ^ (((sb >> 9) & 1) << 5); R = (st >> 1) * 16 + swz / 64; C = (st & 1) * 32 + (swz % 64) / 2; }
__host__ __device__ __forceinline__ int perm32(int rho) { const int n = rho >> 4, i = rho & 15; return 8 * (i >> 2) + 4 * n + (i & 3); }

struct Unit { int pm, pn; };
struct Gemm { const bf16_t* A; const bf16_t* Bt; int M, N, K; };

struct StaticOrder {
    int nM, nN, nwg, G, c;
    __host__ __device__ void init(int M, int N, int G_, int c_) { nM = M / BM; nN = N / BM; nwg = nM * nN; G = G_; c = c_; }
    __host__ __device__ bool next(int i, Unit& u) const {
        const long L = (long)i * G + c; if (L >= nwg) return false;
        int wgid = (int)L; { const int q = nwg / NXCD, r = nwg % NXCD, xcd = wgid % NXCD, off = wgid / NXCD; wgid = (xcd < r ? xcd * (q + 1) : r * (q + 1) + (xcd - r) * q) + off; }
        const int nig = WGM * nN, gid = wgid / nig, fm = gid * WGM, gsz = (nM - fm) < WGM ? (nM - fm) : WGM;
        u.pm = fm + ((wgid % nig) % gsz); u.pn = (wgid % nig) / gsz; return true;
    }
    __device__ __forceinline__ void a_ready(const Unit&) const {}
    __device__ __forceinline__ void done(const Unit&) const {}
};

__device__ __forceinline__ unsigned cvt_pk_bf16(float lo, float hi) { unsigned r; asm volatile("v_cvt_pk_bf16_f32 %0, %1, %2" : "=v"(r) : "v"(lo), "v"(hi)); return r; }
typedef float f32x2 __attribute__((ext_vector_type(2)));
struct EpiStore {
    static constexpr bool PERM = true, AFTER_DRAIN = false;
    bf16_t* O; int ldc;
    __device__ __forceinline__ void operator()(const f32x4 (&acc)[2][2][4][2], const Unit& u, int wr, int wc, int fr, int fq) const {
        const int row0 = u.pm * BM + wr * 64 + fr, col0 = u.pn * BM + wc * 32 + 8 * fq;
#pragma unroll
        for (int ai = 0; ai < 2; ++ai)
#pragma unroll
            for (int m = 0; m < 4; ++m) { bf16_t* rowp = O + (size_t)(row0 + ai * HALF + m * 16) * ldc + col0;
#pragma unroll
                for (int bj = 0; bj < 2; ++bj) { const f32x4 v0 = acc[ai][bj][m][0], v1 = acc[ai][bj][m][1];
                    u32x4 w; w.x = cvt_pk_bf16(v0[0], v0[1]); w.y = cvt_pk_bf16(v0[2], v0[3]); w.z = cvt_pk_bf16(v1[0], v1[1]); w.w = cvt_pk_bf16(v1[2], v1[3]);
                    *(u32x4*)(rowp + bj * HALF) = w; } }
    }
};
__device__ __forceinline__ float silu_mul(float g, float u) { return g * u * __builtin_amdgcn_rcpf(1.0f + __builtin_amdgcn_exp2f(-1.4426950408889634f * g)); }
struct EpiSwiGLU {
    static constexpr bool PERM = true, AFTER_DRAIN = false;
    bf16_t* O; int ldc;
    __device__ __forceinline__ void operator()(const f32x4 (&acc)[2][2][4][2], const Unit& u, int wr, int wc, int fr, int fq) const {
        const int row0 = u.pm * BM + wr * 64 + fr, col0 = u.pn * HALF + wc * 32 + 8 * fq;
#pragma unroll
        for (int ai = 0; ai < 2; ++ai)
#pragma unroll
            for (int m = 0; m < 4; ++m) { bf16_t* rowp = O + (size_t)(row0 + ai * HALF + m * 16) * ldc + col0;
                const f32x4 g0 = acc[ai][0][m][0], g1 = acc[ai][0][m][1], u0 = acc[ai][1][m][0], u1 = acc[ai][1][m][1];
                u32x4 w; w.x = cvt_pk_bf16(silu_mul(g0[0], u0[0]), silu_mul(g0[1], u0[1])); w.y = cvt_pk_bf16(silu_mul(g0[2], u0[2]), silu_mul(g0[3], u0[3]));
                w.z = cvt_pk_bf16(silu_mul(g1[0], u1[0]), silu_mul(g1[1], u1[1])); w.w = cvt_pk_bf16(silu_mul(g1[2], u1[2]), silu_mul(g1[3], u1[3]));
                *(u32x4*)rowp = w; }
    }
};
template <class Epi, class Sched, bool ALIGN_EPI = false, bool SP2 = false>
__device__ __forceinline__ void gemm_phase(PG8_LAS unsigned char* lds, const Gemm g, const Sched& S, const Epi& E) {
    int tid_ = threadIdx.x; asm volatile("" : "+v"(tid_));
    const int tid = tid_, wid = __builtin_amdgcn_readfirstlane(tid >> 6), lane = tid & 63, wr = wid >> 2, wc = wid & 3, fr = lane & 15, fq = lane >> 4;
    const int K = g.K, nt = K / BK;
    unsigned voffA[2], voffB[2];
#pragma unroll
    for (int i = 0; i < 2; ++i) { int R, C; stage_rc(tid * 16 + i * 8192, R, C); const int Rb = Epi::PERM ? ((R & ~31) + perm32(R & 31)) : R;
        voffA[i] = (unsigned)(R * K + C) * 2u; voffB[i] = (unsigned)(Rb * K + C) * 2u; }
    const size_t kstep = (size_t)(BK * 2);
    const size_t hstep = (size_t)HALF * K * 2;
    const size_t tstep = 2 * hstep;
    const unsigned ldsw = (unsigned)wid * 1024u;
    const int aoff = lds_byte(wr * 64 + fr, fq * 8), boff = lds_byte(wc * 32 + fr, fq * 8);
#define PG8_SA(b, h) (((b) * 2 + (h)) * HTB)
#define PG8_SB(b, h) ((4 + (b) * 2 + (h)) * HTB)
#define PG8_STAGE(bufoff, gbase, voff) do { _Pragma("unroll") for (int _i = 0; _i < 2; ++_i) \
        __builtin_amdgcn_global_load_lds((const unsigned*)((const char*)(gbase) + (voff)[_i]), (PG8_LAS unsigned*)(lds + (bufoff) + ldsw + _i * 8192), 16, 0, 0); } while (0)
#define PG8_LDA(dst, b, h) do { _Pragma("unroll") for (int m = 0; m < 4; ++m) _Pragma("unroll") for (int k = 0; k < 2; ++k) dst[m][k] = *(const PG8_LAS bf16x8*)(lds + PG8_SA(b, h) + aoff + m * 2048 + k * 1024); } while (0)
#define PG8_LDB(dst, b, h) do { _Pragma("unroll") for (int n = 0; n < 2; ++n) _Pragma("unroll") for (int k = 0; k < 2; ++k) dst[n][k] = *(const PG8_LAS bf16x8*)(lds + PG8_SB(b, h) + boff + n * 2048 + k * 1024); } while (0)
#define PG8_MMA(ai, bj, At, Bt) do { __builtin_amdgcn_s_setprio(1); _Pragma("unroll") for (int m = 0; m < 4; ++m) _Pragma("unroll") for (int n = 0; n < 2; ++n) _Pragma("unroll") for (int k = 0; k < 2; ++k) \
        acc[ai][bj][m][n] = __builtin_amdgcn_mfma_f32_16x16x32_bf16(Bt[n][k], At[m][k], acc[ai][bj][m][n], 0, 0, 0); __builtin_amdgcn_s_setprio(0); } while (0)
#define PG8_WAIT_V(n) asm volatile("s_waitcnt vmcnt(" #n ")" ::: "memory")
#define PG8_WAIT_L(n) asm volatile("s_waitcnt lgkmcnt(" #n ")" ::: "memory")
#define PG8_BAR __builtin_amdgcn_s_barrier()
#define PG8_SCHED __builtin_amdgcn_sched_barrier(0)
    Unit cur, nxt; int ui = 0;
    if (!S.next(0, cur)) return;
    f32x4 acc[2][2][4][2];
#pragma unroll
    for (int a = 0; a < 2; ++a)
#pragma unroll
        for (int b = 0; b < 2; ++b)
#pragma unroll
            for (int m = 0; m < 4; ++m)
#pragma unroll
                for (int n = 0; n < 2; ++n) acc[a][b][m][n] = (f32x4){0.f, 0.f, 0.f, 0.f};
    bf16x8 At[4][2], B0[2][2], B1[2][2];
    const char* cA = (const char*)g.A + (size_t)cur.pm * tstep; const char* cB = (const char*)g.Bt + (size_t)cur.pn * tstep;
    S.a_ready(cur);
    if constexpr (SP2) {
        PG8_STAGE(PG8_SB(0, 0), cB, voffB); PG8_STAGE(PG8_SB(0, 1), cB + hstep, voffB); PG8_STAGE(PG8_SA(0, 0), cA, voffA); PG8_STAGE(PG8_SA(0, 1), cA + hstep, voffA);
        if (wr == 1) PG8_BAR;
        PG8_WAIT_V(2); PG8_BAR;
        PG8_STAGE(PG8_SB(1, 0), cB + kstep, voffB); PG8_STAGE(PG8_SA(1, 0), cA + kstep, voffA); PG8_STAGE(PG8_SB(1, 1), cB + hstep + kstep, voffB);
        PG8_WAIT_V(6); PG8_BAR;
    } else {
        PG8_STAGE(PG8_SB(0, 0), cB, voffB); PG8_STAGE(PG8_SA(0, 0), cA, voffA); PG8_STAGE(PG8_SB(0, 1), cB + hstep, voffB); PG8_STAGE(PG8_SA(0, 1), cA + hstep, voffA);
        if (wr == 1) PG8_BAR;
        PG8_WAIT_V(4); PG8_BAR;
        PG8_STAGE(PG8_SB(1, 0), cB + kstep, voffB); PG8_STAGE(PG8_SA(1, 0), cA + kstep, voffA); PG8_STAGE(PG8_SB(1, 1), cB + hstep + kstep, voffB);
        PG8_WAIT_V(6); PG8_BAR;
    }
    for (;;) {
        const bool has_next = S.next(ui + 1, nxt);
        const char* nA = has_next ? (const char*)g.A + (size_t)nxt.pm * tstep : cA; const char* nB = has_next ? (const char*)g.Bt + (size_t)nxt.pn * tstep : cB;
        for (int t = 0; t < nt; t += 2) {
            const bool last = (t == nt - 2);
            const char* a1 = cA + (size_t)(t + 1) * kstep;
            const char* a2 = last ? nA : cA + (size_t)(t + 2) * kstep; const char* b2 = last ? nB : cB + (size_t)(t + 2) * kstep;
            const char* a3 = a2 + kstep; const char* b3 = b2 + kstep;
            if (last && has_next) S.a_ready(nxt);
            if constexpr (SP2) {
            PG8_LDB(B0, 0, 0); PG8_LDB(B1, 0, 1); PG8_SCHED; PG8_LDA(At, 0, 0); PG8_STAGE(PG8_SA(1, 1), a1 + hstep, voffA);
            PG8_WAIT_V(8); PG8_WAIT_L(0); PG8_BAR; PG8_MMA(0, 0, At, B0); PG8_MMA(0, 1, At, B1); PG8_BAR; PG8_SCHED;
            PG8_LDA(At, 0, 1); PG8_STAGE(PG8_SB(0, 0), b2, voffB); PG8_STAGE(PG8_SB(0, 1), b2 + hstep, voffB); PG8_STAGE(PG8_SA(0, 0), a2, voffA);
            PG8_WAIT_V(8); PG8_WAIT_L(0); PG8_BAR; PG8_MMA(1, 0, At, B0); PG8_MMA(1, 1, At, B1); PG8_BAR; PG8_SCHED;
            PG8_LDB(B0, 1, 0); PG8_LDB(B1, 1, 1); PG8_SCHED; PG8_LDA(At, 1, 0); PG8_STAGE(PG8_SA(0, 1), a2 + hstep, voffA);
            PG8_WAIT_V(8); PG8_WAIT_L(0); PG8_BAR; PG8_MMA(0, 0, At, B0); PG8_MMA(0, 1, At, B1); PG8_BAR; PG8_SCHED;
            PG8_LDA(At, 1, 1); PG8_STAGE(PG8_SB(1, 0), b3, voffB); PG8_STAGE(PG8_SB(1, 1), b3 + hstep, voffB); PG8_STAGE(PG8_SA(1, 0), a3, voffA);
            PG8_WAIT_V(8); PG8_WAIT_L(0); PG8_BAR; PG8_MMA(1, 0, At, B0); PG8_MMA(1, 1, At, B1); PG8_BAR; PG8_SCHED;
            } else {
            PG8_LDB(B0, 0, 0); PG8_SCHED; PG8_LDA(At, 0, 0); PG8_STAGE(PG8_SA(1, 1), a1 + hstep, voffA);
            PG8_WAIT_L(8); PG8_BAR; PG8_WAIT_L(0); PG8_MMA(0, 0, At, B0); PG8_BAR; PG8_SCHED;
            PG8_LDB(B1, 0, 1); PG8_STAGE(PG8_SB(0, 0), b2, voffB);
            PG8_BAR; PG8_WAIT_L(0); PG8_MMA(0, 1, At, B1); PG8_BAR;
            PG8_LDA(At, 0, 1); PG8_STAGE(PG8_SA(0, 0), a2, voffA);
            PG8_BAR; PG8_WAIT_L(0); PG8_MMA(1, 0, At, B0); PG8_BAR; PG8_SCHED;
            PG8_STAGE(PG8_SB(0, 1), b2 + hstep, voffB);
            PG8_WAIT_V(6); PG8_BAR; PG8_MMA(1, 1, At, B1); PG8_BAR;
            PG8_LDB(B0, 1, 0); PG8_SCHED; PG8_LDA(At, 1, 0); PG8_STAGE(PG8_SA(0, 1), a2 + hstep, voffA);
            PG8_WAIT_L(8); PG8_BAR; PG8_WAIT_L(0); PG8_MMA(0, 0, At, B0); PG8_BAR; PG8_SCHED;
            PG8_LDB(B1, 1, 1); PG8_STAGE(PG8_SB(1, 0), b3, voffB);
            PG8_BAR; PG8_WAIT_L(0); PG8_MMA(0, 1, At, B1); PG8_BAR;
            PG8_LDA(At, 1, 1); PG8_STAGE(PG8_SA(1, 0), a3, voffA);
            PG8_BAR; PG8_WAIT_L(0); PG8_MMA(1, 0, At, B0); PG8_BAR; PG8_SCHED;
            PG8_STAGE(PG8_SB(1, 1), b3 + hstep, voffB);
            PG8_WAIT_V(6); PG8_BAR; PG8_MMA(1, 1, At, B1); PG8_BAR;
            }
        }
        if constexpr (ALIGN_EPI) { if (wr == 0) PG8_BAR; }
        if constexpr (!Epi::AFTER_DRAIN) { E(acc, cur, wr, wc, fr, fq); S.done(cur); }
        if (!has_next) break;
#pragma unroll
        for (int a = 0; a < 2; ++a)
#pragma unroll
            for (int b = 0; b < 2; ++b)
#pragma unroll
                for (int m = 0; m < 4; ++m)
#pragma unroll
                    for (int n = 0; n < 2; ++n) acc[a][b][m][n] = (f32x4){0.f, 0.f, 0.f, 0.f};
        cur = nxt; cA = nA; cB = nB; ++ui;
        if constexpr (ALIGN_EPI) { if (wr == 1) PG8_BAR; }
    }
    PG8_WAIT_V(0);
    if constexpr (!ALIGN_EPI) { if (wr == 0) PG8_BAR; }
    PG8_BAR;
    if constexpr (Epi::AFTER_DRAIN) { E.fused(acc, cur, wr, wc, fr, fq, lds, wid, lane); S.done(cur); }
#undef PG8_SA
#undef PG8_SB
#undef PG8_STAGE
#undef PG8_LDA
#undef PG8_LDB
#undef PG8_MMA
#undef PG8_WAIT_V
#undef PG8_WAIT_L
#undef PG8_BAR
#undef PG8_SCHED
}
}

#define LAS __attribute__((address_space(3)))
#define GAS __attribute__((address_space(1)))
typedef unsigned short bf16;
typedef float f32x4 __attribute__((ext_vector_type(4)));
typedef float f32x16 __attribute__((ext_vector_type(16)));
typedef short bf16x8 __attribute__((ext_vector_type(8)));
typedef short s16x4 __attribute__((ext_vector_type(4)));
typedef unsigned u32x4 __attribute__((ext_vector_type(4)));
typedef unsigned u32x2 __attribute__((ext_vector_type(2)));

constexpr int DM = 1024, NP = 65536, NS = 128, NTOK = NP + NS, MPAD = 65792;
constexpr int SEQ = 8192, PAST = 4096, DSEQ = 16, SKEYS = PAST + DSEQ;
constexpr int KROWS = NP + 8 * SKEYS, KPAD = 98560;
constexpr int DFF = 2816, NGU = 2 * DFF, NIN = 2216, NINP = 2304, QLORA = 384, KVLORA = 256, NQ = 768, NKV = 1024;
constexpr int C_CKV = 384, C_KR = 640, C_FQ = 672, C_FK = 1184, C_FV = 1696, C_FG = 2208;
constexpr float EPS = 1e-6f, LOG2E = 1.4426950408889634f;

constexpr size_t O_Y = 0, O_CKVP = (size_t)NTOK * DM, O_KRP = O_CKVP + (size_t)NP * 256, O_FKP = O_KRP + (size_t)NP * 32, O_FVP = O_FKP + (size_t)NP * 512,
                 O_LFP = O_FVP + (size_t)NP * 512, O_CKVS = O_LFP + (size_t)NP * 8, O_KRS = O_CKVS + (size_t)NS * 256, O_FKS = O_KRS + (size_t)NS * 32,
                 O_FVS = O_FKS + (size_t)NS * 512, O_LFS = O_FVS + (size_t)NS * 512, O_END = O_LFS + (size_t)NS * 8;

constexpr size_t al256(size_t x) { return (x + 255) & ~(size_t)255; }
constexpr size_t WS_WGU1 = 0, WS_WD1 = WS_WGU1 + al256((size_t)NGU * DM * 2), WS_WGU2 = WS_WD1 + al256((size_t)DM * DFF * 2), WS_WD2 = WS_WGU2 + al256((size_t)NGU * DM * 2),
                 WS_WIN = WS_WD2 + al256((size_t)DM * DFF * 2), WS_WQ = WS_WIN + al256((size_t)NINP * DM * 2), WS_WKV = WS_WQ + al256((size_t)NQ * QLORA * 2),
                 WS_WO = WS_WKV + al256((size_t)NKV * KVLORA * 2), WS_TAB = WS_WO + al256((size_t)DM * DM * 2), WS_LK = WS_TAB + al256((size_t)SEQ * 16 * 8),
                 WS_LFS = WS_LK + al256((size_t)KPAD * 8 * 4), WS_KROPE = WS_LFS + al256((size_t)8 * SKEYS * 8 * 4), WS_XN = WS_KROPE + al256((size_t)KPAD * 32 * 2),
                 WS_D = WS_XN + al256((size_t)MPAD * DM * 2), WS_ACT = WS_D + al256((size_t)MPAD * DM * 2), WS_QM = WS_ACT + al256((size_t)MPAD * DFF * 2),
                 WS_KV = WS_QM + al256((size_t)MPAD * NQ * 2), WS_QCTR = WS_KV + al256((size_t)KPAD * NKV * 2), WS_BAR = WS_QCTR + 4096, WS_END = WS_BAR + 16384;
constexpr size_t WS_PROJ = WS_ACT, WS_CQN = WS_PROJ + al256((size_t)MPAD * NINP * 2);
constexpr size_t WS_CKVN = WS_D, WS_FKS = WS_CKVN + al256((size_t)KPAD * KVLORA * 2), WS_FVS = WS_FKS + al256((size_t)(8 * SKEYS + 64) * 512 * 2);
static_assert(WS_CQN + (size_t)MPAD * QLORA * 2 <= WS_QM, "overlay 1");
static_assert(WS_FVS + (size_t)(8 * SKEYS + 64) * 512 * 2 <= WS_ACT, "overlay 2");

constexpr int LDS_BYTES = 135168;

struct Args { const float* in[24]; float* out; unsigned char* ws; };
constexpr int PTR_OFF = 131072;
struct Ctx {
    LAS unsigned char* lds;
    __device__ __forceinline__ unsigned long long raw(int i) const { const unsigned long long v = *(const LAS unsigned long long*)(lds + PTR_OFF + 8 * i);
        const unsigned lo = __builtin_amdgcn_readfirstlane((unsigned)v), hi = __builtin_amdgcn_readfirstlane((unsigned)(v >> 32)); return ((unsigned long long)hi << 32) | lo; }
    __device__ __forceinline__ const float* in(int i) const { return (const float*)raw(i); }
    __device__ __forceinline__ float* out() const { return (float*)raw(24); }
    __device__ __forceinline__ unsigned char* ws() const { return (unsigned char*)raw(25); }
};
enum { I_XP = 0, I_XS, I_CCKV, I_CKR, I_CFK, I_CFV, I_CLF, I_G1PRE, I_G1POST, I_W1GU, I_W1D, I_GMPRE, I_GMPOST, I_WIN, I_BF, I_GQ, I_WQ, I_GKV, I_WKV, I_WO, I_G2PRE, I_G2POST, I_W2GU, I_W2D };

__device__ __forceinline__ unsigned f2bf(float f) { unsigned u = __builtin_bit_cast(unsigned, f); return (u + 0x7fffu + ((u >> 16) & 1u)) >> 16; }
__device__ __forceinline__ unsigned pk2(float lo, float hi) { return pg8::cvt_pk_bf16(lo, hi); }
__device__ __forceinline__ float bf2f(unsigned short b) { return __builtin_bit_cast(float, (unsigned)b << 16); }
__device__ __forceinline__ float bflo(unsigned w) { return __builtin_bit_cast(float, w << 16); }
__device__ __forceinline__ float bfhi(unsigned w) { return __builtin_bit_cast(float, w & 0xffff0000u); }
__device__ __forceinline__ float wave_sum(float v) {
#pragma unroll
    for (int o = 1; o < 64; o <<= 1) v += __shfl_xor(v, o);
    return v;
}
__device__ __forceinline__ int keyrow(int n) { return n < NP ? n : NP + ((n - NP) >> 4) * SKEYS + PAST + ((n - NP) & 15); }
__device__ __forceinline__ int rowpos(int n) { return n < NP ? (n & (SEQ - 1)) : PAST + ((n - NP) & 15); }

struct MapId  { __device__ __forceinline__ int col(int c) const { return c; } };
struct MapGU  { __device__ __forceinline__ int col(int c) const { return ((c >> 7) & 1) * DFF + (c >> 8) * 128 + (c & 127); } };
struct MapIn  { __device__ __forceinline__ int col(int c) const { return c < NIN ? c : -1; } };
struct MapQ   { __device__ __forceinline__ int col(int c) const { const int h = c / 96, w = c % 96; if (w < 64) return c; const int p = w - 64; return h * 96 + 64 + ((p & 1) ? (p >> 1) + 16 : (p >> 1)); } };
template <class Map> __device__ __forceinline__ void transpose_w(const float* W, int K, int Nsrc, bf16* WT, int Ndst, Map map, LAS float* scr, int gw, int NGW, int lane) {
    const int nblk = Ndst / 32, items = (K / 64) * nblk;
    for (int it = gw; it < items; it += NGW) {
        const int kb = it / nblk, nb = it % nblk, k0 = 64 * kb, n0 = 32 * nb;
        const int sc = map.col(n0 + (lane & 31));
#pragma unroll 8
        for (int i = 0; i < 32; ++i) { const int kk = 2 * i + (lane >> 5); scr[kk * 33 + (lane & 31)] = sc >= 0 ? W[(size_t)(k0 + kk) * Nsrc + sc] : 0.f; }
        asm volatile("s_waitcnt lgkmcnt(0)" ::: "memory");
        const int c = lane & 7;
#pragma unroll
        for (int j = 0; j < 4; ++j) { const int n = (lane >> 3) + 8 * j; const LAS float* s = scr + (8 * c) * 33 + n;
            u32x4 o; o.x = pk2(s[0 * 33], s[1 * 33]); o.y = pk2(s[2 * 33], s[3 * 33]); o.z = pk2(s[4 * 33], s[5 * 33]); o.w = pk2(s[6 * 33], s[7 * 33]);
            *(u32x4*)(WT + (size_t)(n0 + n) * K + k0 + 8 * c) = o; }
        asm volatile("s_waitcnt lgkmcnt(0)" ::: "memory");
    }
}
template <class Map> __device__ __forceinline__ void transpose_w4(const float* W, int K, int Nsrc, bf16* WT, int Ndst, Map map, LAS float* scr, int gw, int NGW, int lane) {
    const int nblk = Ndst / 32, items = (K / 64) * nblk;
    const int kq = lane >> 3, c4 = lane & 7;
    for (int it = gw; it < items; it += NGW) {
        const int kb = it / nblk, nb = it % nblk, k0 = 64 * kb, n0 = 32 * nb;
        const float* src = W + (size_t)(k0 + kq) * Nsrc + map.col(n0) + 4 * c4;
        f32x4 v[8];
#pragma unroll
        for (int i = 0; i < 8; ++i) v[i] = *(const GAS f32x4*)(src + (size_t)(8 * i) * Nsrc);
#pragma unroll
        for (int i = 0; i < 8; ++i) { LAS float* d = scr + (8 * i + kq) * 33 + 4 * c4; d[0] = v[i][0]; d[1] = v[i][1]; d[2] = v[i][2]; d[3] = v[i][3]; }
        asm volatile("s_waitcnt lgkmcnt(0)" ::: "memory");
        const int c = lane & 7;
#pragma unroll
        for (int j = 0; j < 4; ++j) { const int n = (lane >> 3) + 8 * j; const LAS float* s = scr + (8 * c) * 33 + n;
            u32x4 o; o.x = pk2(s[0 * 33], s[1 * 33]); o.y = pk2(s[2 * 33], s[3 * 33]); o.z = pk2(s[4 * 33], s[5 * 33]); o.w = pk2(s[6 * 33], s[7 * 33]);
            *(GAS u32x4*)(WT + (size_t)(n0 + n) * K + k0 + 8 * c) = o; }
        asm volatile("s_waitcnt lgkmcnt(0)" ::: "memory");
    }
}
__device__ __forceinline__ void rope_cs(int pos, int i, float& c, float& s) {
    double f = 1.0; for (int k = 0; k < i; ++k) f *= 0.56234132519034908;
    const double ang = (double)pos * f;
    const double q = __builtin_rint(ang * 0.63661977236758134);
    const double y = (ang - q * 1.5707963267948966) - q * 6.123233995736766e-17;
    const double y2 = y * y;
    const double sn = y * (1.0 + y2 * (-1.0 / 6 + y2 * (1.0 / 120 + y2 * (-1.0 / 5040 + y2 * (1.0 / 362880 + y2 * (-1.0 / 39916800 + y2 * (1.0 / 6227020800.0)))))));
    const double cs = 1.0 + y2 * (-0.5 + y2 * (1.0 / 24 + y2 * (-1.0 / 720 + y2 * (1.0 / 40320 + y2 * (-1.0 / 3628800 + y2 * (1.0 / 479001600 + y2 * (-1.0 / 87178291200.0)))))));
    const int qi = (int)((long long)q & 3);
    const double cc = (qi == 0) ? cs : (qi == 1) ? -sn : (qi == 2) ? -cs : sn;
    const double ss = (qi == 0) ? sn : (qi == 1) ? cs : (qi == 2) ? -sn : -cs;
    c = (float)cc; s = (float)ss;
}

__device__ __forceinline__ void load16_f32(const float* p, int lane, float (&v)[16]) {
#pragma unroll
    for (int j = 0; j < 2; ++j) { const f32x4 a = *(const f32x4*)(p + 8 * lane + 512 * j), b = *(const f32x4*)(p + 8 * lane + 512 * j + 4);
        v[8 * j + 0] = a[0]; v[8 * j + 1] = a[1]; v[8 * j + 2] = a[2]; v[8 * j + 3] = a[3]; v[8 * j + 4] = b[0]; v[8 * j + 5] = b[1]; v[8 * j + 6] = b[2]; v[8 * j + 7] = b[3]; }
}
__device__ __forceinline__ void load16_bf16(const bf16* p, int lane, float (&v)[16]) {
#pragma unroll
    for (int j = 0; j < 2; ++j) { const u32x4 a = *(const u32x4*)(p + 8 * lane + 512 * j);
        v[8 * j + 0] = bflo(a.x); v[8 * j + 1] = bfhi(a.x); v[8 * j + 2] = bflo(a.y); v[8 * j + 3] = bfhi(a.y); v[8 * j + 4] = bflo(a.z); v[8 * j + 5] = bfhi(a.z); v[8 * j + 6] = bflo(a.w); v[8 * j + 7] = bfhi(a.w); }
}
__device__ __forceinline__ void store16_f32(float* p, int lane, const float (&v)[16]) {
#pragma unroll
    for (int j = 0; j < 2; ++j) { *(f32x4*)(p + 8 * lane + 512 * j) = (f32x4){v[8 * j], v[8 * j + 1], v[8 * j + 2], v[8 * j + 3]}; *(f32x4*)(p + 8 * lane + 512 * j + 4) = (f32x4){v[8 * j + 4], v[8 * j + 5], v[8 * j + 6], v[8 * j + 7]}; }
}
__device__ __forceinline__ void store16_f32_nt(float* p, int lane, const float (&v)[16]) {
#pragma unroll
    for (int j = 0; j < 2; ++j) { __builtin_nontemporal_store((f32x4){v[8 * j], v[8 * j + 1], v[8 * j + 2], v[8 * j + 3]}, (f32x4*)(p + 8 * lane + 512 * j)); __builtin_nontemporal_store((f32x4){v[8 * j + 4], v[8 * j + 5], v[8 * j + 6], v[8 * j + 7]}, (f32x4*)(p + 8 * lane + 512 * j + 4)); }
}
__device__ __forceinline__ void store16_bf16(bf16* p, int lane, const float (&v)[16]) {
#pragma unroll
    for (int j = 0; j < 2; ++j) { u32x4 o; o.x = pk2(v[8 * j], v[8 * j + 1]); o.y = pk2(v[8 * j + 2], v[8 * j + 3]); o.z = pk2(v[8 * j + 4], v[8 * j + 5]); o.w = pk2(v[8 * j + 6], v[8 * j + 7]); *(u32x4*)(p + 8 * lane + 512 * j) = o; }
}
__device__ __forceinline__ float ssq16(const float (&v)[16]) { float s = 0.f;
#pragma unroll
    for (int i = 0; i < 16; ++i) s += v[i] * v[i];
    return wave_sum(s); }
__device__ __forceinline__ void rp_norm_only(const Ctx& a, const float* g, bf16* XN, int gw, int NGW, int lane) {
    float gv[16]; load16_f32(g, lane, gv); const float* xp = a.in(I_XP); const float* xs = a.in(I_XS);
    for (int n = gw; n < NTOK; n += NGW) {
        const float* xr = n < NP ? xp + (size_t)n * DM : xs + (size_t)(n - NP) * DM;
        float v[16]; load16_f32(xr, lane, v);
        const float rs = 1.0f / sqrtf(ssq16(v) * (1.0f / DM) + EPS);
#pragma unroll
        for (int i = 0; i < 16; ++i) v[i] = v[i] * rs * gv[i];
        store16_bf16(XN + (size_t)n * DM, lane, v);
    }
}
__device__ __forceinline__ void rp_residual(const Ctx& a, bool base_is_x, bool final_y, const bf16* D, float coef, const float* gpost, const float* gnext, float* hout, bf16* XN, int n0, int n1, int gw, int NGW, int lane) {
    const float* xp = a.in(I_XP); const float* xs = a.in(I_XS);
    for (int n = n0 + gw; n < n1; n += NGW) {
        float v[16], d[16], g[16];
        if (base_is_x) load16_f32(n < NP ? xp + (size_t)n * DM : xs + (size_t)(n - NP) * DM, lane, v); else load16_bf16((const bf16*)(hout + (size_t)n * DM), lane, v);
        load16_bf16(D + (size_t)n * DM, lane, d); load16_f32(gpost, lane, g);
        const float rs = coef / sqrtf(ssq16(d) * (1.0f / DM) + EPS);
#pragma unroll
        for (int i = 0; i < 16; ++i) v[i] = v[i] + d[i] * rs * g[i];
        if (final_y) store16_f32_nt(hout + (size_t)n * DM, lane, v); else store16_bf16((bf16*)(hout + (size_t)n * DM), lane, v);
        if (gnext) {
            load16_f32(gnext, lane, g);
            const float rs2 = 1.0f / sqrtf(ssq16(v) * (1.0f / DM) + EPS);
#pragma unroll
            for (int i = 0; i < 16; ++i) v[i] = v[i] * rs2 * g[i];
            store16_bf16(XN + (size_t)n * DM, lane, v);
        }
    }
}
__device__ __forceinline__ void rp_mix(const Ctx& a, int n0, int n1, bool do_cache, int gw, int NGW, int lane) {
    unsigned char* ws = a.ws(); float* out = a.out();
    const bf16* PROJ = (const bf16*)(ws + WS_PROJ); bf16* CQN = (bf16*)(ws + WS_CQN); bf16* CKVN = (bf16*)(ws + WS_CKVN); bf16* KROPE = (bf16*)(ws + WS_KROPE);
    bf16* FKS = (bf16*)(ws + WS_FKS); bf16* FVS = (bf16*)(ws + WS_FVS); float* LFS = (float*)(ws + WS_LFS); const float* TAB = (const float*)(ws + WS_TAB);
    const float* gq = a.in(I_GQ); const float* gkv = a.in(I_GKV); const float* bfg = a.in(I_BF);
    for (int n = n0 + gw; n < n1; n += NGW) {
        const bf16* pr = PROJ + (size_t)n * NINP; const bool smp = n >= NP; const int ns = n - NP; const int kr = keyrow(n);
        { const unsigned* p = (const unsigned*)(pr + 6 * lane); const unsigned w0 = p[0], w1 = p[1], w2 = p[2];
          float v[6] = {bflo(w0), bfhi(w0), bflo(w1), bfhi(w1), bflo(w2), bfhi(w2)}; float s = 0.f;
#pragma unroll
          for (int i = 0; i < 6; ++i) s += v[i] * v[i];
          const float rs = 1.0f / sqrtf(wave_sum(s) * (1.0f / QLORA) + EPS);
#pragma unroll
          for (int i = 0; i < 6; ++i) v[i] = v[i] * rs * gq[6 * lane + i];
          unsigned* o = (unsigned*)(CQN + (size_t)n * QLORA + 6 * lane); o[0] = pk2(v[0], v[1]); o[1] = pk2(v[2], v[3]); o[2] = pk2(v[4], v[5]); }
        { const u32x2 w = *(const u32x2*)(pr + C_CKV + 4 * lane); float v[4] = {bflo(w.x), bfhi(w.x), bflo(w.y), bfhi(w.y)};
          const float rs = 1.0f / sqrtf(wave_sum(v[0] * v[0] + v[1] * v[1] + v[2] * v[2] + v[3] * v[3]) * (1.0f / KVLORA) + EPS);
          const f32x4 g = *(const f32x4*)(gkv + 4 * lane); const f32x4 r = {v[0] * rs * g[0], v[1] * rs * g[1], v[2] * rs * g[2], v[3] * rs * g[3]};
          __builtin_nontemporal_store(r, (f32x4*)(out + (smp ? O_CKVS + (size_t)ns * 256 : O_CKVP + (size_t)n * 256) + 4 * lane));
          u32x2 o; o.x = pk2(r[0], r[1]); o.y = pk2(r[2], r[3]); *(u32x2*)(CKVN + (size_t)kr * KVLORA + 4 * lane) = o; }
        if (lane < 16) { const float x1 = bf2f(pr[C_KR + lane]), x2 = bf2f(pr[C_KR + 16 + lane]); const int pos = rowpos(n);
          const float c = TAB[((size_t)pos * 16 + lane) * 2], s = TAB[((size_t)pos * 16 + lane) * 2 + 1];
          const float o1 = x1 * c - x2 * s, o2 = x1 * s + x2 * c; float* kr_out = out + (smp ? O_KRS + (size_t)ns * 32 : O_KRP + (size_t)n * 32);
          kr_out[lane] = o1; kr_out[16 + lane] = o2; *(unsigned*)(KROPE + (size_t)kr * 32 + 2 * lane) = pk2(o1, o2); }
        { const u32x4 wk = *(const u32x4*)(pr + C_FK + 8 * lane), wv = *(const u32x4*)(pr + C_FV + 8 * lane);
          float* ko = out + (smp ? O_FKS + (size_t)ns * 512 : O_FKP + (size_t)n * 512) + 8 * lane; float* vo = out + (smp ? O_FVS + (size_t)ns * 512 : O_FVP + (size_t)n * 512) + 8 * lane;
          __builtin_nontemporal_store((f32x4){bflo(wk.x), bfhi(wk.x), bflo(wk.y), bfhi(wk.y)}, (f32x4*)ko); __builtin_nontemporal_store((f32x4){bflo(wk.z), bfhi(wk.z), bflo(wk.w), bfhi(wk.w)}, (f32x4*)(ko + 4));
          __builtin_nontemporal_store((f32x4){bflo(wv.x), bfhi(wv.x), bflo(wv.y), bfhi(wv.y)}, (f32x4*)vo); __builtin_nontemporal_store((f32x4){bflo(wv.z), bfhi(wv.z), bflo(wv.w), bfhi(wv.w)}, (f32x4*)(vo + 4));
          if (smp) { *(u32x4*)(FKS + (size_t)(kr - NP) * 512 + 8 * lane) = wk; *(u32x4*)(FVS + (size_t)(kr - NP) * 512 + 8 * lane) = wv; } }
        if (lane < 8) { const float z = bf2f(pr[C_FG + lane]) + bfg[lane]; const float lf = fminf(z, 0.f) - log1pf(expf(-fabsf(z)));
          out[(smp ? O_LFS + (size_t)ns * 8 : O_LFP + (size_t)n * 8) + lane] = lf; if (smp) LFS[(size_t)(kr - NP) * 8 + lane] = lf; }
    }
    if (!do_cache) return;
    int lane_ = lane; asm volatile("" : "+v"(lane_));
    const unsigned gt = (unsigned)gw * 64u + (unsigned)lane_, NT = (unsigned)NGW * 64u;
    { const float* src = a.in(I_CCKV);
      for (unsigned e = gt; e < 8u * PAST * 256 / 8; e += NT) { const unsigned row = e >> 5, c = (e & 31) * 8; const unsigned b = row >> 12, j = row & 4095;
        const f32x4 x = *(const f32x4*)(src + (size_t)row * 256 + c), y = *(const f32x4*)(src + (size_t)row * 256 + c + 4);
        u32x4 o; o.x = pk2(x[0], x[1]); o.y = pk2(x[2], x[3]); o.z = pk2(y[0], y[1]); o.w = pk2(y[2], y[3]); *(u32x4*)(CKVN + ((size_t)NP + b * SKEYS + j) * 256 + c) = o; } }
    { const float* srck = a.in(I_CFK); const float* srcv = a.in(I_CFV);
      for (unsigned e = gt; e < 8u * PAST * 512 / 8; e += NT) { const unsigned row = e >> 6, c = (e & 63) * 8; const unsigned b = row >> 12, j = row & 4095;
        f32x4 x = *(const f32x4*)(srck + (size_t)row * 512 + c), y = *(const f32x4*)(srck + (size_t)row * 512 + c + 4);
        u32x4 o; o.x = pk2(x[0], x[1]); o.y = pk2(x[2], x[3]); o.z = pk2(y[0], y[1]); o.w = pk2(y[2], y[3]); *(u32x4*)(FKS + (size_t)(b * SKEYS + j) * 512 + c) = o;
        x = *(const f32x4*)(srcv + (size_t)row * 512 + c); y = *(const f32x4*)(srcv + (size_t)row * 512 + c + 4);
        o.x = pk2(x[0], x[1]); o.y = pk2(x[2], x[3]); o.z = pk2(y[0], y[1]); o.w = pk2(y[2], y[3]); *(u32x4*)(FVS + (size_t)(b * SKEYS + j) * 512 + c) = o; } }
    { const float* src = a.in(I_CKR);
      for (unsigned e = gt; e < 8u * PAST * 16; e += NT) { const unsigned row = e >> 4, i = e & 15; const unsigned b = row >> 12, j = row & 4095;
        *(unsigned*)(KROPE + ((size_t)NP + b * SKEYS + j) * 32 + 2 * i) = pk2(src[(size_t)row * 32 + i], src[(size_t)row * 32 + 16 + i]); } }
    { const float* src = a.in(I_CLF);
      for (unsigned e = gt; e < 8u * PAST * 8; e += NT) { const unsigned row = e >> 3, h = e & 7; const unsigned b = row >> 12, j = row & 4095; LFS[(size_t)(b * SKEYS + j) * 8 + h] = src[e]; } }
}
__device__ __forceinline__ void scan_item(const float* src, float* dst, int len, LAS float* sm, int tid) {
    const int per = (len + 511) / 512, i0 = tid * per, i1 = min(len, i0 + per);
    float s = 0.f; for (int i = i0; i < i1; ++i) s += src[(size_t)i * 8];
    const int lane = tid & 63, wid = tid >> 6; float inc = s;
#pragma unroll
    for (int o = 1; o < 64; o <<= 1) { const float t = __shfl_up(inc, o); if (lane >= o) inc += t; }
    __syncthreads();
    if (lane == 63) sm[wid] = inc;
    __syncthreads();
    float pre = 0.f; for (int w = 0; w < wid; ++w) pre += sm[w];
    float run = pre + inc - s;
    for (int i = i0; i < i1; ++i) { run += src[(size_t)i * 8]; dst[(size_t)i * 8] = run; }
}

struct AttnUnit { const bf16* Q; const bf16* K; const bf16* KR; const bf16* V; const float* LK; const float* TAB; bf16* O; int qpitch, kpitch, vpitch, nkeys, qpos0, nq; };
constexpr int A_KP = 208, A_VP = 192, A_KB = 64 * A_KP, A_VB = 64 * A_VP, A_STG = A_KB + A_VB + 256, A_WS = 2 * A_STG;
__device__ __forceinline__ int crow(int r, int hi) { return (r & 3) + 8 * (r >> 2) + 4 * hi; }
typedef float f32x2_t __attribute__((ext_vector_type(2))); typedef __bf16 bf16x2_t __attribute__((ext_vector_type(2)));
__device__ __forceinline__ unsigned cvtpk(float lo, float hi) { f32x2_t v = {lo, hi}; bf16x2_t b = __builtin_convertvector(v, bf16x2_t); return __builtin_bit_cast(unsigned, b); }
#define MX3(a, b, c) __builtin_fmaxf(__builtin_fmaxf((a), (b)), (c))
template <int TYPE> __device__ __forceinline__ void attn_unit(LAS unsigned char* lds, const AttnUnit& U) {
    constexpr int ND = TYPE == 0 ? 6 : 4;
    constexpr float SC = (TYPE == 0 ? 0.10206207261596575f : 0.125f) * LOG2E;
    constexpr float THR = 40.0f;
    int tid_ = threadIdx.x; asm volatile("" : "+v"(tid_));
    const int tid = tid_, lane = tid & 63, wid = __builtin_amdgcn_readfirstlane(tid >> 6), r32 = lane & 31, hi = lane >> 5;
    const int NT = (U.qpos0 + (U.nq > 32 ? 256 : 32) - 1) / 64 + 1;
    const bool active = wid * 32 < U.nq;
    const int NTw = active ? (U.qpos0 + 32 * wid + 31) / 64 + 1 : 0;
    LAS float* wsf = (LAS float*)(lds + 82944) + wid * 64;
#define A_KS(s) ((s) * 12288)
#define A_VS(s) (49152 + (s) * 8192)
#define A_BS(s) (81920 + (s) * 256)
    const unsigned lds0 = (unsigned)(uintptr_t)lds;
    const int lastrow = U.nkeys - 1 - 64 * (NT - 1);
    const int lr8 = 8 * wid + (lane >> 3);
    const int kch = (lane & 7) ^ ((4 * wid + (lane >> 4)) & 7);
    const int vch = (lane & 7) ^ (((lane >> 4) & 1) * 4);
    const int rr16 = 16 * (wid & 3) + (lane >> 2), rch = (lane & 3) ^ ((lane >> 4) & 3);
    const unsigned voK = (unsigned)(lr8 * U.kpitch * 2 + 16 * kch), voKl = (unsigned)(min(lr8, lastrow) * U.kpitch * 2 + 16 * kch);
    const unsigned voV = (unsigned)(lr8 * U.vpitch * 2 + 16 * vch), voVl = (unsigned)(min(lr8, lastrow) * U.vpitch * 2 + 16 * vch);
    const unsigned voA = TYPE == 0 ? (unsigned)(rr16 * 64 + 16 * rch) : (unsigned)(lane * 32), voAl = TYPE == 0 ? (unsigned)(min(rr16, lastrow) * 64 + 16 * rch) : (unsigned)(min(lane, lastrow) * 32);
#define A_DMA16(vo, sb, dst) do { unsigned keep_; asm volatile("s_mov_b32 %0, m0\n\ts_mov_b32 m0, %3\n\ts_nop 0\n\tglobal_load_lds_dwordx4 %1, %2\n\ts_mov_b32 m0, %0" : "=&s"(keep_) : "v"(vo), "s"(sb), "s"(dst) : "memory"); } while (0)
#define A_DMA4(vo, sb, dst) do { unsigned keep_; asm volatile("s_mov_b32 %0, m0\n\ts_mov_b32 m0, %3\n\ts_nop 0\n\tglobal_load_lds_dword %1, %2\n\ts_mov_b32 m0, %0" : "=&s"(keep_) : "v"(vo), "s"(sb), "s"(dst) : "memory"); } while (0)
#define A_DMAK(t, slot) do { const int tc_ = min((int)(t), NT - 1); const bool l_ = tc_ == NT - 1; \
        const bf16* kb_ = U.K + (size_t)(64 * tc_) * U.kpitch; \
        A_DMA16(l_ ? voKl : voK, kb_, (unsigned)__builtin_amdgcn_readfirstlane(lds0 + A_KS(slot) + wid * 1024)); \
        if (TYPE == 0) { const bf16* rb_ = U.KR + (size_t)(64 * tc_) * 32; A_DMA16(l_ ? voAl : voA, rb_, (unsigned)__builtin_amdgcn_readfirstlane(lds0 + A_KS(slot) + 8192 + (wid & 3) * 1024)); } \
        else { const float* bb_ = U.LK + (size_t)(64 * tc_) * 8; A_DMA4(l_ ? voAl : voA, bb_, (unsigned)__builtin_amdgcn_readfirstlane(lds0 + A_BS(slot))); } } while (0)
#define A_DMAV(t, slot) do { const int tc_ = min((int)(t), NT - 1); const bool l_ = tc_ == NT - 1; const bf16* vb_ = U.V + (size_t)(64 * tc_) * U.vpitch; \
        A_DMA16(l_ ? voVl : voV, vb_, (unsigned)__builtin_amdgcn_readfirstlane(lds0 + A_VS(slot) + wid * 1024)); } while (0)
#define A_SB() __builtin_amdgcn_sched_barrier(0)
#define A_PINW() asm volatile("" : "+v"(pw[0]), "+v"(pw[1]), "+v"(pw[2]), "+v"(pw[3]))
#define A_PINP() asm volatile("" : "+v"(p0), "+v"(p1))
#define A_PK1(c) do { if ((c) < 16) { const int i_ = 2 * (c); pw[(c) >> 2][(c) & 3] = cvtpk(i_ < 16 ? p0[i_ & 15] : p1[i_ & 15], i_ < 16 ? p0[(i_ + 1) & 15] : p1[(i_ + 1) & 15]); } } while (0)
    unsigned kad[ND];
#pragma unroll
    for (int d0 = 0; d0 < ND; ++d0) kad[d0] = lds0 + (d0 < 4 ? r32 * 128 + 16 * ((2 * d0 + hi) ^ ((r32 >> 1) & 7)) : 8192 + r32 * 64 + 16 * ((2 * (d0 - 4) + hi) ^ ((r32 >> 2) & 3)));
    const int vq_ = (lane & 15) >> 2, vp_ = lane & 3, vsw_ = ((vq_ >> 1) & 1) * 4, vck_ = 2 * ((lane >> 4) & 1) + (vp_ >> 1);
    const unsigned vad0 = lds0 + (4 * hi + vq_) * 128 + 16 * (vck_ ^ vsw_) + 8 * (vp_ & 1), vad1 = lds0 + (4 * hi + vq_) * 128 + 16 * ((4 + vck_) ^ vsw_) + 8 * (vp_ & 1);
    const unsigned bad = lds0 + 16 * hi;
#define A_LDK(d0, half) (*(const LAS bf16x8*)(uintptr_t)(kcur[d0] + (half) * ((d0) < 4 ? 32 * 128 : 32 * 64)))
#define A_QKPRE(SK, s0, s1) \
        unsigned kcur[ND]; \
        _Pragma("unroll") for (int d0 = 0; d0 < ND; ++d0) kcur[d0] = kad[d0] + (unsigned)A_KS(SK); \
        if (TYPE == 1) { const float nm_ = -mref; const unsigned bcur = bad + (unsigned)A_BS(SK); \
            _Pragma("unroll") for (int g = 0; g < 4; ++g) { const f32x4 b0 = *(const LAS f32x4*)(uintptr_t)(bcur + 32 * g), b1 = *(const LAS f32x4*)(uintptr_t)(bcur + 128 + 32 * g); \
                _Pragma("unroll") for (int i = 0; i < 4; ++i) { s0[4 * g + i] = __builtin_fmaf(b0[i], -LOG2E, nm_); s1[4 * g + i] = __builtin_fmaf(b1[i], -LOG2E, nm_); } } \
        } else { s0 = negm; s1 = negm; } \
        bf16x8 ka0 = A_LDK(0, 0), ka1 = A_LDK(0, 1);
#define A_QK(SK, s0, s1, PACK) do { \
        A_SB(); \
        _Pragma("unroll") for (int d0 = 0; d0 < ND; ++d0) { \
            bf16x8 kn0 = ka0, kn1 = ka1; \
            if (d0 + 1 < ND) { kn0 = A_LDK((d0 + 1 < ND ? d0 + 1 : 0), 0); kn1 = A_LDK((d0 + 1 < ND ? d0 + 1 : 0), 1); } \
            s0 = __builtin_amdgcn_mfma_f32_32x32x16_bf16(ka0, qf[d0], s0, 0, 0, 0); \
            if (PACK) { A_PK1(4 * d0); A_PK1(4 * d0 + 1); A_PINW(); } \
            A_SB(); \
            s1 = __builtin_amdgcn_mfma_f32_32x32x16_bf16(ka1, qf[d0], s1, 0, 0, 0); \
            if (PACK) { A_PK1(4 * d0 + 2); A_PK1(4 * d0 + 3); A_PINW(); } \
            A_SB(); \
            ka0 = kn0; ka1 = kn1; } } while (0)
#define A_PACK() do { _Pragma("unroll") for (int c = 0; c < 16; ++c) A_PK1(c); } while (0)
#define A_MASK(t, s0, s1) do { const int qpos = U.qpos0 + 32 * wid + r32; \
        _Pragma("unroll") for (int r = 0; r < 16; ++r) { const int kv = 64 * (t) + crow(r, hi); \
            if (!(kv < U.nkeys && (TYPE == 0 || kv <= qpos))) s0[r] = -INFINITY; \
            if (!(kv + 32 < U.nkeys && (TYPE == 0 || kv + 32 <= qpos))) s1[r] = -INFINITY; } } while (0)
#define A_ROWMAX(s0, s1, mt) do { float ma = MX3(s0[0], s0[1], s1[0]), mb = MX3(s0[2], s0[3], s1[1]); ma = MX3(ma, s1[2], s1[3]); \
        _Pragma("unroll") for (int r = 4; r < 16; r += 4) { ma = MX3(ma, s0[r], s0[r + 1]); mb = MX3(mb, s0[r + 2], s0[r + 3]); ma = MX3(ma, s1[r], s1[r + 1]); mb = MX3(mb, s1[r + 2], s1[r + 3]); } \
        mt = fmaxf(ma, mb); { const auto rr_ = __builtin_amdgcn_permlane32_swap(__float_as_uint(mt), __float_as_uint(mt), false, false); mt = fmaxf(__uint_as_float(rr_[0]), __uint_as_float(rr_[1])); } } while (0)
#define A_TR(a) __builtin_bit_cast(s16x4, __builtin_amdgcn_ds_read_tr16_b64_v4i16((LAS s16x4*)(uintptr_t)(a)))
#define A_VRD(dst0, dst1, kk_, SV) do { const int kvb_ = 32 * ((kk_) >> 1) + 16 * ((kk_) & 1); \
        const s16x4 l0_ = A_TR(vcur0 + kvb_ * 128), h0_ = A_TR(vcur0 + (kvb_ + 8) * 128), l1_ = A_TR(vcur1 + kvb_ * 128), h1_ = A_TR(vcur1 + (kvb_ + 8) * 128); \
        dst0 = (bf16x8){l0_[0], l0_[1], l0_[2], l0_[3], h0_[0], h0_[1], h0_[2], h0_[3]}; dst1 = (bf16x8){l1_[0], l1_[1], l1_[2], l1_[3], h1_[0], h1_[1], h1_[2], h1_[3]}; } while (0)
#define A_EX0(r, sv) p0[r] = __builtin_amdgcn_exp2f(sv[r])
#define A_EX1(r, sv) p1[r] = __builtin_amdgcn_exp2f(sv[r])
#define A_PV(SV, EXPS, s0, s1) do { \
        const unsigned vcur0 = vad0 + (unsigned)A_VS(SV), vcur1 = vad1 + (unsigned)A_VS(SV); \
        bf16x8 va0, va1; A_VRD(va0, va1, 0, SV); \
        A_SB(); \
        _Pragma("unroll") for (int kk = 0; kk < 4; ++kk) { \
            const bf16x8 pk_ = __builtin_bit_cast(bf16x8, pw[kk]); \
            bf16x8 vn0 = va0, vn1 = va1; \
            o2 = __builtin_amdgcn_mfma_f32_32x32x16_bf16(pk_, ones, o2, 0, 0, 0); \
            if (EXPS) { A_EX0(4 * kk, s0); A_EX0(4 * kk + 1, s0); A_EX1(4 * kk, s1); A_PINP(); } \
            if (kk + 1 < 4) A_VRD(vn0, vn1, kk + 1, SV); \
            A_SB(); \
            o0 = __builtin_amdgcn_mfma_f32_32x32x16_bf16(pk_, va0, o0, 0, 0, 0); \
            if (EXPS) { A_EX0(4 * kk + 2, s0); A_EX1(4 * kk + 1, s1); A_EX1(4 * kk + 2, s1); A_PINP(); } \
            A_SB(); \
            o1 = __builtin_amdgcn_mfma_f32_32x32x16_bf16(pk_, va1, o1, 0, 0, 0); \
            if (EXPS) { A_EX0(4 * kk + 3, s0); A_EX1(4 * kk + 3, s1); A_PINP(); } \
            A_SB(); \
            va0 = vn0; va1 = vn1; } } while (0)
    float mref = 0.f;
    f32x16 o0 = {}, o1 = {}, o2 = {}, negm = {}, p0 = {}, p1 = {};
    u32x4 pw[4] = {};
    const bf16x8 ones = {0x3F80, 0x3F80, 0x3F80, 0x3F80, 0x3F80, 0x3F80, 0x3F80, 0x3F80};
#define A_WAITBAR(n) asm volatile("s_waitcnt vmcnt(" #n ") lgkmcnt(0)\n\ts_barrier" ::: "memory")
    A_DMAK(0, 0); A_DMAK(1, 1); A_DMAV(0, 0);
    bf16x8 qf[ND];
    { int qrow = wid * 32 + r32; if (qrow >= U.nq) qrow = U.nq - 1;
      const bf16* qp = U.Q + (size_t)qrow * U.qpitch + hi * 8;
#pragma unroll
      for (int d0 = 0; d0 < ND; ++d0) qf[d0] = *(const GAS bf16x8*)(qp + d0 * 16);
#pragma unroll
      for (int d0 = 0; d0 < ND; ++d0) {
          u32x4 w = __builtin_bit_cast(u32x4, qf[d0]);
          if (TYPE == 0 && d0 >= 4) {
              const float* tb = U.TAB + (size_t)(U.qpos0 + qrow) * 32; const int pb = 8 * (d0 - 4) + 4 * hi; const f32x4 t0 = *(const GAS f32x4*)(tb + 2 * pb), t1 = *(const GAS f32x4*)(tb + 2 * pb + 4);
              { const float x1 = bflo(w.x), x2 = bfhi(w.x); w.x = cvtpk((x1 * t0[0] - x2 * t0[1]) * SC, (x1 * t0[1] + x2 * t0[0]) * SC); }
              { const float x1 = bflo(w.y), x2 = bfhi(w.y); w.y = cvtpk((x1 * t0[2] - x2 * t0[3]) * SC, (x1 * t0[3] + x2 * t0[2]) * SC); }
              { const float x1 = bflo(w.z), x2 = bfhi(w.z); w.z = cvtpk((x1 * t1[0] - x2 * t1[1]) * SC, (x1 * t1[1] + x2 * t1[0]) * SC); }
              { const float x1 = bflo(w.w), x2 = bfhi(w.w); w.w = cvtpk((x1 * t1[2] - x2 * t1[3]) * SC, (x1 * t1[3] + x2 * t1[2]) * SC); }
          } else { w.x = cvtpk(bflo(w.x) * SC, bfhi(w.x) * SC); w.y = cvtpk(bflo(w.y) * SC, bfhi(w.y) * SC); w.z = cvtpk(bflo(w.z) * SC, bfhi(w.z) * SC); w.w = cvtpk(bflo(w.w) * SC, bfhi(w.w) * SC); }
          qf[d0] = __builtin_bit_cast(bf16x8, w); } }
    A_WAITBAR(0);
#define A_TOP(t, d1_, d2_) do { if ((((t)) & 1) == 0) { A_DMAK((t) + 2, ((t) + 2) & 3); A_DMAK((t) + 3, ((t) + 3) & 3); A_DMAV((t) + 1, ((t) + 1) & 3); A_DMAV((t) + 2, ((t) + 2) & 3); } } while (0)
#define A_BOT() do { if (t & 1) { A_WAITBAR(0); } } while (0)
    int t = 0, sk = 0, sk2 = 3;
    const int sk1 = 0; (void)sk1;
#define A_ROT() do { sk = (t + 1) & 3; sk2 = t & 3; } while (0)
    {
        if (NTw > 0) {
            f32x16 s0, s1;
            A_QKPRE(sk, s0, s1)
            A_TOP(0, sk2, sk1);
            A_QK(sk, s0, s1, false);
            if (NTw == 1) A_MASK(0, s0, s1);
            float mt; A_ROWMAX(s0, s1, mt);
            mref = mt;
#pragma unroll
            for (int r = 0; r < 16; ++r) { if (TYPE == 0) negm[r] = -mref; p0[r] = __builtin_amdgcn_exp2f(s0[r] - mt); p1[r] = __builtin_amdgcn_exp2f(s1[r] - mt); }
        } else { A_TOP(0, sk2, sk1); }
        A_BOT(); A_ROT();
    }
    for (t = 1; t < NTw; ++t) {
        f32x16 s0, s1;
        A_QKPRE(sk, s0, s1)
        A_TOP(t, sk2, sk1);
        A_QK(sk, s0, s1, true);
        if (t == NTw - 1) A_MASK(t, s0, s1);
        float mt; A_ROWMAX(s0, s1, mt);
        bool resc = false;
        if (__any(mt > THR)) {
            const float dl = fmaxf(mt, 0.f); mref += dl;
#pragma unroll
            for (int r = 0; r < 16; ++r) { s0[r] -= dl; s1[r] -= dl; if (TYPE == 0) negm[r] = -mref; }
            if (hi == 0) wsf[r32] = __builtin_amdgcn_exp2f(-dl);
            resc = true;
        }
        A_PV(sk2, true, s0, s1);
        if (resc) {
            asm volatile("s_waitcnt lgkmcnt(0)" ::: "memory");
#pragma unroll
            for (int g = 0; g < 4; ++g) { const f32x4 al = *(const LAS f32x4*)(wsf + 8 * g + 4 * hi);
#pragma unroll
                for (int i = 0; i < 4; ++i) { o0[4 * g + i] *= al[i]; o1[4 * g + i] *= al[i]; o2[4 * g + i] *= al[i]; } }
            asm volatile("s_waitcnt lgkmcnt(0)" ::: "memory");
        }
        A_BOT(); A_ROT();
    }
    if (NTw > 0) {
        A_TOP(t, sk2, sk1);
        A_PACK();
        A_PV(sk2, false, p0, p1);
        A_BOT(); A_ROT();
        ++t;
    }
    for (; t <= NT; ++t) { A_TOP(t, sk2, sk1); A_BOT(); A_ROT(); }
    asm volatile("s_waitcnt vmcnt(0)" ::: "memory");
    if (active) {
#pragma unroll
        for (int r = 0; r < 16; ++r) { const int q = wid * 32 + crow(r, hi);
            if (q < U.nq) { const float il = __builtin_amdgcn_rcpf(o2[r]); GAS bf16* op = (GAS bf16*)(U.O + (size_t)q * DM + r32); op[0] = (bf16)f2bf(o0[r] * il); op[32] = (bf16)f2bf(o1[r] * il); } }
    }
    __syncthreads();
#undef A_KS
#undef A_VS
#undef A_BS
#undef A_DMA16
#undef A_DMA4
#undef A_DMAK
#undef A_DMAV
#undef A_SB
#undef A_PINW
#undef A_PINP
#undef A_PK1
#undef A_LDK
#undef A_QKPRE
#undef A_QK
#undef A_PACK
#undef A_MASK
#undef A_ROWMAX
#undef A_TR
#undef A_VRD
#undef A_EX0
#undef A_EX1
#undef A_PV
#undef A_WAITBAR
#undef A_TOP
#undef A_BOT
#undef A_ROT
}
__device__ __forceinline__ void attn_phase(const Ctx& a, LAS unsigned char* lds) {
    unsigned char* ws = a.ws();
    const bf16* PROJ = (const bf16*)(ws + WS_PROJ); const bf16* QM = (const bf16*)(ws + WS_QM); const bf16* KV = (const bf16*)(ws + WS_KV); const bf16* KROPE = (const bf16*)(ws + WS_KROPE);
    const bf16* FKS = (const bf16*)(ws + WS_FKS); const bf16* FVS = (const bf16*)(ws + WS_FVS); const float* LKB = (const float*)(ws + WS_LK); bf16* OB = (bf16*)(ws + WS_XN);
    unsigned* qctr = (unsigned*)(ws + WS_QCTR);
    const int myx = (int)(__builtin_amdgcn_s_getreg((3 << 11) | 20) & 7u);
    LAS int* slot = (LAS int*)(lds + PTR_OFF + 256);
    int qoff = 0;
    for (;;) {
        if (threadIdx.x == 0) {
            int e = -1, x = 0;
            while (qoff < 8) { x = (myx + qoff) & 7; const unsigned v = atomicAdd(qctr + 64 * x, 1u); if (v < 272u) { e = (int)v; break; } ++qoff; }
            slot[0] = e; slot[1] = x;
        }
        __syncthreads();
        const int e = slot[0], x = slot[1];
        __syncthreads();
        if (e < 0) break;
        const int nhalf = e < 256 ? 2 : 1;
        for (int half = 0; half < nhalf; ++half) {
            AttnUnit U; int type; U.TAB = (const float*)(ws + WS_TAB);
            if (e < 256) {
                const int ks = e >> 4, jj = e & 15;
                const int s = x + 8 * ks; type = s >> 6; const int b = (s >> 3) & 7, h = s & 7, qb = half ? 31 - jj : jj; const size_t r0 = (size_t)b * SEQ, q0 = r0 + 256 * qb;
                U.nkeys = SEQ; U.qpos0 = 256 * qb; U.nq = 256;
                if (type == 0) { U.Q = QM + q0 * NQ + 96 * h; U.qpitch = NQ; U.K = KV + r0 * NKV + 128 * h; U.kpitch = NKV; U.KR = KROPE + r0 * 32; U.V = KV + r0 * NKV + 128 * h + 64; U.vpitch = NKV; U.LK = nullptr; U.O = OB + q0 * DM + 64 * h; }
                else { U.Q = PROJ + q0 * NINP + C_FQ + 64 * h; U.qpitch = NINP; U.K = PROJ + r0 * NINP + C_FK + 64 * h; U.kpitch = NINP; U.KR = nullptr; U.V = PROJ + r0 * NINP + C_FV + 64 * h; U.vpitch = NINP; U.LK = LKB + r0 * 8 + h; U.O = OB + q0 * DM + 512 + 64 * h; }
            } else {
                const int j = e - 256; type = j >> 3; const int b = j & 7, h = x; const size_t q0 = (size_t)NP + 16 * b, r0 = (size_t)NP + (size_t)b * SKEYS;
                U.nkeys = SKEYS; U.qpos0 = PAST; U.nq = DSEQ;
                if (type == 0) { U.Q = QM + q0 * NQ + 96 * h; U.qpitch = NQ; U.K = KV + r0 * NKV + 128 * h; U.kpitch = NKV; U.KR = KROPE + r0 * 32; U.V = KV + r0 * NKV + 128 * h + 64; U.vpitch = NKV; U.LK = nullptr; U.O = OB + q0 * DM + 64 * h; }
                else { U.Q = PROJ + q0 * NINP + C_FQ + 64 * h; U.qpitch = NINP; U.K = FKS + (size_t)b * SKEYS * 512 + 64 * h; U.kpitch = 512; U.KR = nullptr; U.V = FVS + (size_t)b * SKEYS * 512 + 64 * h; U.vpitch = 512; U.LK = LKB + r0 * 8 + h; U.O = OB + q0 * DM + 512 + 64 * h; }
            }
            if (type == 0) attn_unit<0>(lds, U); else attn_unit<1>(lds, U);
        }
    }
}

template <class Epi> __device__ __forceinline__ void run_gemm(LAS unsigned char* lds, const bf16* A, const bf16* Bt, int M, int N, int K, const Epi& E) {
    pg8::Gemm g{A, Bt, M, N, K}; pg8::StaticOrder S; S.init(M, N, (int)gridDim.x, (int)blockIdx.x);
    pg8::gemm_phase<Epi, pg8::StaticOrder, true, true>(lds, g, S, E);
}
#define XB_TMO      128
#define XB_XCNT(j)  (256  + 64 * (j))
#define XB_XSUB(j)  (1280 + 64 * (j))
#define XB_XGEN(j)  (2304 + 64 * (j))
#define XB_TOP      3328
#define XB_TOPGEN   3392
#define XCD_BAR_WORDS 3456
#define XB_SPIN_CAP (1u << 18)

__device__ __forceinline__ unsigned xb_ld(unsigned* p)              { return __hip_atomic_load(p, __ATOMIC_RELAXED, __HIP_MEMORY_SCOPE_AGENT); }
__device__ __forceinline__ unsigned xb_add(unsigned* p, unsigned v) { return __hip_atomic_fetch_add(p, v, __ATOMIC_RELAXED, __HIP_MEMORY_SCOPE_AGENT); }
__device__ __forceinline__ unsigned xb_xcc_id() { return (unsigned)__builtin_amdgcn_s_getreg((3 << 11) | 20) & 0xFu; }
#define XB_SPIN(cond, bar) do { unsigned _sp = 0; while (cond) { __builtin_amdgcn_s_sleep(1); \
    if ((++_sp & 255u) == 0u) { if (xb_ld(&(bar)[XB_TMO])) break; if (_sp > XB_SPIN_CAP) { atomicAdd(&(bar)[XB_TMO], 1u); break; } } } } while (0)

struct XcdBarrier {
    unsigned* bar; unsigned x;
    volatile LAS unsigned* st;
};

__device__ __forceinline__ XcdBarrier xcd_barrier_post(unsigned* bar, volatile LAS unsigned* st) {
    XcdBarrier b; b.bar = bar; b.x = xb_xcc_id(); b.st = st;
    if (threadIdx.x == 0) (void)xb_add(&bar[XB_XCNT(b.x)], 1u);
    return b;
}
__device__ __forceinline__ void xcd_barrier_complete(unsigned* bar, unsigned x, unsigned& nloc, unsigned& nx) {
    const unsigned G = gridDim.x * gridDim.y * gridDim.z;
    unsigned sum, cnt, mine, sp = 0u;
    for (;;) {
        sum = 0u; cnt = 0u; mine = 0u;
#pragma unroll
        for (unsigned j = 0; j < 16; ++j) { const unsigned c = xb_ld(&bar[XB_XCNT(j)]); sum += c; cnt += (c > 0u) ? 1u : 0u; mine = (j == x) ? c : mine; }
        if (sum == G) break;
        __builtin_amdgcn_s_sleep(1);
        if ((++sp & 255u) == 0u) { if (xb_ld(&bar[XB_TMO])) break; if (sp > XB_SPIN_CAP) { atomicAdd(&bar[XB_TMO], 1u); break; } }
    }
    nloc = mine > 0u ? mine : 1u; nx = cnt > 0u ? cnt : 1u;
}

__device__ __forceinline__ void xcd_barrier(const XcdBarrier& b) {
    asm volatile("s_waitcnt vmcnt(0)" ::: "memory");
    __syncthreads();
    if (threadIdx.x == 0) {
        unsigned* bar = b.bar;
        __builtin_amdgcn_s_waitcnt(0);
        unsigned nloc = b.st[0], nx = b.st[1];
        if (nloc == 0u) { xcd_barrier_complete(bar, b.x, nloc, nx); b.st[0] = nloc; b.st[1] = nx; }
        const unsigned old = xb_add(&bar[XB_XSUB(b.x)], 1u);
        const unsigned gen = old / nloc;
        if (old + 1u == (gen + 1u) * nloc) {
            __builtin_amdgcn_fence(__ATOMIC_RELEASE, "agent");
            asm volatile("s_waitcnt vmcnt(0)" ::: "memory");
            const unsigned og = xb_add(&bar[XB_TOP], 1u);
            const unsigned tg = og / nx;
            if (og + 1u == (tg + 1u) * nx) xb_add(&bar[XB_TOPGEN], 1u);
            else XB_SPIN(xb_ld(&bar[XB_TOPGEN]) == tg, bar);
            __builtin_amdgcn_fence(__ATOMIC_ACQUIRE, "agent");
            xb_add(&bar[XB_XGEN(b.x)], 1u);
            asm volatile("s_waitcnt vmcnt(0)" ::: "memory");
        } else {
            XB_SPIN(xb_ld(&bar[XB_XGEN(b.x)]) == gen, bar);
            __builtin_amdgcn_fence(__ATOMIC_ACQUIRE, "agent");
            asm volatile("s_waitcnt vmcnt(0)" ::: "memory");
        }
    }
    __syncthreads();
}

__device__ __forceinline__ void blk_signal(unsigned* flag) { __threadfence(); __syncthreads(); if (threadIdx.x == 0) __hip_atomic_fetch_add(flag, 1u, __ATOMIC_RELEASE, __HIP_MEMORY_SCOPE_AGENT); }
__device__ __forceinline__ void blk_wait(unsigned* flag, unsigned n) {
    if (threadIdx.x == 0) { while (__hip_atomic_load(flag, __ATOMIC_ACQUIRE, __HIP_MEMORY_SCOPE_AGENT) < n) __builtin_amdgcn_s_sleep(8); }
    __syncthreads(); __threadfence();
}
__global__ void __launch_bounds__(512, 2) mega_fwd(Args a) {
    extern __shared__ __attribute__((aligned(16))) unsigned char lds_raw[];
    LAS unsigned char* lds = (LAS unsigned char*)lds_raw;
    cg::grid_group grid = cg::this_grid();
#define PH_IDS() int tid_l_ = threadIdx.x; asm volatile("" : "+v"(tid_l_)); const int tid = tid_l_, lane = tid & 63, wave = __builtin_amdgcn_readfirstlane(tid >> 6), gw = blockIdx.x * 8 + wave, NGW = gridDim.x * 8; (void)tid; (void)lane; (void)wave; (void)gw; (void)NGW
    { const unsigned long long* ka = (const unsigned long long*)__builtin_amdgcn_kernarg_segment_ptr(); const int tid = threadIdx.x;
      if (tid < 26) *(LAS unsigned long long*)(lds + PTR_OFF + 8 * tid) = ka[tid];
      if (tid < 2) *(LAS unsigned*)(lds + PTR_OFF + 512 + 4 * tid) = 0u; }
    __syncthreads();
    const Ctx c{lds};
#define WSP(T, off) ((T*)(c.ws() + (off)))
    { PH_IDS(); LAS float* scr = (LAS float*)(lds + wave * 16384);
      transpose_w4(c.in(I_W1GU), DM, NGU, WSP(bf16, WS_WGU1), NGU, MapGU(), scr, gw, NGW, lane);
      transpose_w4(c.in(I_W1D), DFF, DM, WSP(bf16, WS_WD1), DM, MapId(), scr, gw, NGW, lane);
      transpose_w4(c.in(I_W2GU), DM, NGU, WSP(bf16, WS_WGU2), NGU, MapGU(), scr, gw, NGW, lane);
      transpose_w4(c.in(I_W2D), DFF, DM, WSP(bf16, WS_WD2), DM, MapId(), scr, gw, NGW, lane);
      transpose_w(c.in(I_WIN), DM, NIN, WSP(bf16, WS_WIN), NINP, MapIn(), scr, gw, NGW, lane);
      transpose_w(c.in(I_WQ), QLORA, NQ, WSP(bf16, WS_WQ), NQ, MapQ(), scr, gw, NGW, lane);
      transpose_w4(c.in(I_WKV), KVLORA, NKV, WSP(bf16, WS_WKV), NKV, MapId(), scr, gw, NGW, lane);
      transpose_w4(c.in(I_WO), DM, DM, WSP(bf16, WS_WO), DM, MapId(), scr, gw, NGW, lane);
      { float* TAB = WSP(float, WS_TAB); for (int e = gw * 64 + lane; e < SEQ * 16; e += NGW * 64) { float cc, ss; rope_cs(e >> 4, e & 15, cc, ss); TAB[2 * e] = cc; TAB[2 * e + 1] = ss; } }
      if (blockIdx.x == 0 && tid < 16) WSP(unsigned, WS_QCTR)[64 * tid] = 0u;
      if (blockIdx.x == 1) { for (int w = tid; w < XCD_BAR_WORDS; w += 512) WSP(unsigned, WS_BAR)[w] = 0u; }
      rp_norm_only(c, c.in(I_G1PRE), WSP(bf16, WS_XN), gw, NGW, lane); }
    grid.sync();
    const XcdBarrier xbar = xcd_barrier_post(WSP(unsigned, WS_BAR), (volatile LAS unsigned*)(lds + PTR_OFF + 512));
#define GSYNC() xcd_barrier(xbar)
#define FLAG(i) (WSP(unsigned, WS_QCTR) + 512 + 64 * (i))
#define SROW(T, off, ld) (WSP(T, off) + (size_t)NP * (ld))
    run_gemm(lds, WSP(bf16, WS_XN), WSP(bf16, WS_WGU1), MPAD, NGU, DM, pg8::EpiSwiGLU{WSP(bf16, WS_ACT), DFF});
    GSYNC();
    run_gemm(lds, WSP(bf16, WS_ACT), WSP(bf16, WS_WD1), NP, DM, DFF, pg8::EpiStore{WSP(bf16, WS_D), DM});
    GSYNC();
    if (blockIdx.x < 4) {
        run_gemm(lds, SROW(bf16, WS_ACT, DFF), WSP(bf16, WS_WD1), 256, DM, DFF, pg8::EpiStore{SROW(bf16, WS_D, DM), DM}); blk_signal(FLAG(1));
        { blk_wait(FLAG(1), 4); PH_IDS(); rp_residual(c, true, false, WSP(bf16, WS_D), 0.5f, c.in(I_G1POST), c.in(I_GMPRE), c.out(), WSP(bf16, WS_XN), NP, NTOK, gw, 4 * 8, lane); }
    } else { PH_IDS(); rp_residual(c, true, false, WSP(bf16, WS_D), 0.5f, c.in(I_G1POST), c.in(I_GMPRE), c.out(), WSP(bf16, WS_XN), 0, NP, gw - 4 * 8, NGW - 4 * 8, lane);
    }
    GSYNC();
    run_gemm(lds, WSP(bf16, WS_XN), WSP(bf16, WS_WIN), NP, NINP, DM, pg8::EpiStore{WSP(bf16, WS_PROJ), NINP});
    GSYNC();
    if (blockIdx.x < 9) {
        run_gemm(lds, SROW(bf16, WS_XN, DM), WSP(bf16, WS_WIN), 256, NINP, DM, pg8::EpiStore{SROW(bf16, WS_PROJ, NINP), NINP});
        blk_signal(FLAG(2));
        { blk_wait(FLAG(2), 9); PH_IDS(); rp_mix(c, NP, NTOK, false, gw, 9 * 8, lane); }
    } else { PH_IDS(); rp_mix(c, 0, NP, true, gw - 9 * 8, NGW - 9 * 8, lane); }
    GSYNC();
    run_gemm(lds, WSP(bf16, WS_CQN), WSP(bf16, WS_WQ), MPAD, NQ, QLORA, pg8::EpiStore{WSP(bf16, WS_QM), NQ});
    run_gemm(lds, WSP(bf16, WS_CKVN), WSP(bf16, WS_WKV), KPAD, NKV, KVLORA, pg8::EpiStore{WSP(bf16, WS_KV), NKV});
    for (int i = blockIdx.x; i < 128; i += gridDim.x) {
        PH_IDS(); const int b = (i >> 3) & 7, h = i & 7;
        if (i < 64) scan_item(c.out() + O_LFP + (size_t)b * SEQ * 8 + h, WSP(float, WS_LK) + (size_t)b * SEQ * 8 + h, SEQ, (LAS float*)lds, tid);
        else scan_item(WSP(float, WS_LFS) + (size_t)b * SKEYS * 8 + h, WSP(float, WS_LK) + ((size_t)NP + (size_t)b * SKEYS) * 8 + h, SKEYS, (LAS float*)lds, tid);
        __syncthreads();
    }
    GSYNC();
    attn_phase(c, lds);
    GSYNC();
    run_gemm(lds, WSP(bf16, WS_XN), WSP(bf16, WS_WO), NP, DM, DM, pg8::EpiStore{WSP(bf16, WS_D), DM});
    GSYNC();
    if (blockIdx.x < 4) {
        run_gemm(lds, SROW(bf16, WS_XN, DM), WSP(bf16, WS_WO), 256, DM, DM, pg8::EpiStore{SROW(bf16, WS_D, DM), DM});
        blk_signal(FLAG(3));
        { blk_wait(FLAG(3), 4); PH_IDS(); rp_residual(c, false, false, WSP(bf16, WS_D), 1.0f, c.in(I_GMPOST), c.in(I_G2PRE), c.out(), WSP(bf16, WS_XN), NP, NTOK, gw, 4 * 8, lane); }
    } else { PH_IDS(); rp_residual(c, false, false, WSP(bf16, WS_D), 1.0f, c.in(I_GMPOST), c.in(I_G2PRE), c.out(), WSP(bf16, WS_XN), 0, NP, gw - 4 * 8, NGW - 4 * 8, lane);
    }
    GSYNC();
    run_gemm(lds, WSP(bf16, WS_XN), WSP(bf16, WS_WGU2), MPAD, NGU, DM, pg8::EpiSwiGLU{WSP(bf16, WS_ACT), DFF});
    GSYNC();
    run_gemm(lds, WSP(bf16, WS_ACT), WSP(bf16, WS_WD2), NP, DM, DFF, pg8::EpiStore{WSP(bf16, WS_D), DM});
    GSYNC();
    if (blockIdx.x < 4) {
        run_gemm(lds, SROW(bf16, WS_ACT, DFF), WSP(bf16, WS_WD2), 256, DM, DFF, pg8::EpiStore{SROW(bf16, WS_D, DM), DM}); blk_signal(FLAG(5));
        { blk_wait(FLAG(5), 4); PH_IDS(); rp_residual(c, false, true, WSP(bf16, WS_D), 0.5f, c.in(I_G2POST), nullptr, c.out(), WSP(bf16, WS_XN), NP, NTOK, gw, 4 * 8, lane); }
    } else { PH_IDS(); rp_residual(c, false, true, WSP(bf16, WS_D), 0.5f, c.in(I_G2POST), nullptr, c.out(), WSP(bf16, WS_XN), 0, NP, gw - 4 * 8, NGW - 4 * 8, lane);
    }
#undef FLAG
#undef SROW
#undef WSP
#undef PH_IDS
#undef GSYNC
}

extern "C" void kernel_launch(void* const* d_in, const int* in_sizes, int n_in, void* d_out, int out_size, void* d_ws, size_t ws_size, hipStream_t stream) {
    static int grid_blocks = 0;
    if (grid_blocks == 0) {
        if (n_in != 24 || (size_t)out_size != O_END || ws_size < WS_END) { fprintf(stderr, "kernel_launch: unexpected shapes: n_in %d out %d ws %zu (need %zu)\n", n_in, out_size, ws_size, (size_t)WS_END); grid_blocks = -1; return; }
        int dev = 0, cus = 0, per_cu = 0;
        hipGetDevice(&dev); hipDeviceGetAttribute(&cus, hipDeviceAttributeMultiprocessorCount, dev);
        if (hipFuncSetAttribute((const void*)mega_fwd, hipFuncAttributeMaxDynamicSharedMemorySize, LDS_BYTES) != hipSuccess) { fprintf(stderr, "kernel_launch: hipFuncSetAttribute failed\n"); grid_blocks = -1; return; }
        if (hipOccupancyMaxActiveBlocksPerMultiprocessor(&per_cu, (const void*)mega_fwd, 512, LDS_BYTES) != hipSuccess || per_cu < 1) { fprintf(stderr, "kernel_launch: occupancy query says %d\n", per_cu); per_cu = 1; (void)hipGetLastError(); }
        grid_blocks = cus * per_cu;
    }
    if (grid_blocks < 0) return;
    Args a{};
    for (int i = 0; i < 24; ++i) a.in[i] = (const float*)d_in[i];
    a.out = (float*)d_out; a.ws = (unsigned char*)d_ws;
    void* args[] = {&a};
    hipError_t e = hipLaunchCooperativeKernel((const void*)mega_fwd, dim3(grid_blocks), dim3(512), args, LDS_BYTES, stream);
    if (e != hipSuccess) fprintf(stderr, "cooperative launch failed: %s (grid %d)\n", hipGetErrorString(e), grid_blocks);
}
```

```cpp
#include <hip/hip_runtime.h>
#include <hip/hip_cooperative_groups.h>
#include <cstdio>
#include <cstdint>
namespace cg = cooperative_groups;
namespace pg8 {
#define PG8_LAS __attribute__((address_space(3)))
typedef unsigned short bf16_t;
typedef short bf16x8 __attribute__((ext_vector_type(8)));
typedef float f32x4 __attribute__((ext_vector_type(4)));
typedef unsigned u32x4 __attribute__((ext_vector_type(4)));
constexpr int BM = 256, BK = 64, HALF = 128, HTB = HALF * BK * 2  , STAGE_BYTES = 8 * HTB, NXCD = 8, WGM = 8;

__host__ __device__ __forceinline__ int lds_byte(int r, int c) { const int st = (r >> 4) * 2 + (c >> 5), rr = r & 15, cc = c & 31, ob = rr * 64 + cc * 2; return st * 1024 + (ob ^ (((ob >> 9) & 1) << 5)); }
__host__ __device__ __forceinline__ void stage_rc(int b, int& R, int& C) { const int st = b / 1024, sb = b % 1024, swz = sb ^ (((sb >> 9) & 1) << 5); R = (st >> 1) * 16 + swz / 64; C = (st & 1) * 32 + (swz % 64) / 2; }
__host__ __device__ __forceinline__ int perm32(int rho) { const int n = rho >> 4, i = rho & 15; return 8 * (i >> 2) + 4 * n + (i & 3); }

struct Unit { int pm, pn; };
struct Gemm { const bf16_t* A; const bf16_t* Bt; int M, N, K; };

struct StaticOrder {
    int nM, nN, nwg, G, c;
    __host__ __device__ void init(int M, int N, int G_, int c_) { nM = M / BM; nN = N / BM; nwg = nM * nN; G = G_; c = c_; }
    __host__ __device__ bool next(int i, Unit& u) const {
        const long L = (long)i * G + c; if (L >= nwg) return false;
        int wgid = (int)L; { const int q = nwg / NXCD, r = nwg % NXCD, xcd = wgid % NXCD, off = wgid / NXCD; wgid = (xcd < r ? xcd * (q + 1) : r * (q + 1) + (xcd - r) * q) + off; }
        const int nig = WGM * nN, gid = wgid / nig, fm = gid * WGM, gsz = (nM - fm) < WGM ? (nM - fm) : WGM;
        u.pm = fm + ((wgid % nig) % gsz); u.pn = (wgid % nig) / gsz; return true;
    }
    __device__ __forceinline__ void a_ready(const Unit&) const {}
    __device__ __forceinline__ void done(const Unit&) const {}
};

__device__ __forceinline__ unsigned cvt_pk_bf16(float lo, float hi) { unsigned r; asm volatile("v_cvt_pk_bf16_f32 %0, %1, %2" : "=v"(r) : "v"(lo), "v"(hi)); return r; }
typedef float f32x2 __attribute__((ext_vector_type(2)));
struct EpiStore {
    static constexpr bool PERM = true, AFTER_DRAIN = false;
    bf16_t* O; int ldc;
    __device__ __forceinline__ void operator()(const f32x4 (&acc)[2][2][4][2], const Unit& u, int wr, int wc, int fr, int fq) const {
        const int row0 = u.pm * BM + wr * 64 + fr, col0 = u.pn * BM + wc * 32 + 8 * fq;
#pragma unroll
        for (int ai = 0; ai < 2; ++ai)
#pragma unroll
            for (int m = 0; m < 4; ++m) { bf16_t* rowp = O + (size_t)(row0 + ai * HALF + m * 16) * ldc + col0;
#pragma unroll
                for (int bj = 0; bj < 2; ++bj) { const f32x4 v0 = acc[ai][bj][m][0], v1 = acc[ai][bj][m][1];
                    u32x4 w; w.x = cvt_pk_bf16(v0[0], v0[1]); w.y = cvt_pk_bf16(v0[2], v0[3]); w.z = cvt_pk_bf16(v1[0], v1[1]); w.w = cvt_pk_bf16(v1[2], v1[3]);
                    *(u32x4*)(rowp + bj * HALF) = w; } }
    }
};
__device__ __forceinline__ float silu_mul(float g, float u) { return g * u * __builtin_amdgcn_rcpf(1.0f + __builtin_amdgcn_exp2f(-1.4426950408889634f * g)); }
struct EpiSwiGLU {
    static constexpr bool PERM = true, AFTER_DRAIN = false;
    bf16_t* O; int ldc;
    __device__ __forceinline__ void operator()(const f32x4 (&acc)[2][2][4][2], const Unit& u, int wr, int wc, int fr, int fq) const {
        const int row0 = u.pm * BM + wr * 64 + fr, col0 = u.pn * HALF + wc * 32 + 8 * fq;
#pragma unroll
        for (int ai = 0; ai < 2; ++ai)
#pragma unroll
            for (int m = 0; m < 4; ++m) { bf16_t* rowp = O + (size_t)(row0 + ai * HALF + m * 16) * ldc + col0;
                const f32x4 g0 = acc[ai][0][m][0], g1 = acc[ai][0][m][1], u0 = acc[ai][1][m][0], u1 = acc[ai][1][m][1];
                u32x4 w; w.x = cvt_pk_bf16(silu_mul(g0[0], u0[0]), silu_mul(g0[1], u0[1])); w.y = cvt_pk_bf16(silu_mul(g0[2], u0[2]), silu_mul(g0[3], u0[3]));
                w.z = cvt_pk_bf16(silu_mul(g1[0], u1[0]), silu_mul(g1[1], u1[1])); w.w = cvt_pk_bf16(silu_mul(g1[2], u1[2]), silu_mul(g1[3], u1[3]));
                *(u32x4*)rowp = w; }
    }
};
template <class Epi, class Sched, bool ALIGN_EPI = false, bool SP2 = false>
__device__ __forceinline__ void gemm_phase(PG8_LAS unsigned char* lds, const Gemm g, const Sched& S, const Epi& E) {
    int tid_ = threadIdx.x; asm volatile("" : "+v"(tid_));
    const int tid = tid_, wid = __builtin_amdgcn_readfirstlane(tid >> 6), lane = tid & 63, wr = wid >> 2, wc = wid & 3, fr = lane & 15, fq = lane >> 4;
    const int K = g.K, nt = K / BK;
    unsigned voffA[2], voffB[2];
#pragma unroll
    for (int i = 0; i < 2; ++i) { int R, C; stage_rc(tid * 16 + i * 8192, R, C); const int Rb = Epi::PERM ? ((R & ~31) + perm32(R & 31)) : R;
        voffA[i] = (unsigned)(R * K + C) * 2u; voffB[i] = (unsigned)(Rb * K + C) * 2u; }
    const size_t kstep = (size_t)(BK * 2);
    const size_t hstep = (size_t)HALF * K * 2;
    const size_t tstep = 2 * hstep;
    const unsigned ldsw = (unsigned)wid * 1024u;
    const int aoff = lds_byte(wr * 64 + fr, fq * 8), boff = lds_byte(wc * 32 + fr, fq * 8);
#define PG8_SA(b, h) (((b) * 2 + (h)) * HTB)
#define PG8_SB(b, h) ((4 + (b) * 2 + (h)) * HTB)
#define PG8_STAGE(bufoff, gbase, voff) do { _Pragma("unroll") for (int _i = 0; _i < 2; ++_i) \
        __builtin_amdgcn_global_load_lds((const unsigned*)((const char*)(gbase) + (voff)[_i]), (PG8_LAS unsigned*)(lds + (bufoff) + ldsw + _i * 8192), 16, 0, 0); } while (0)
#define PG8_LDA(dst, b, h) do { _Pragma("unroll") for (int m = 0; m < 4; ++m) _Pragma("unroll") for (int k = 0; k < 2; ++k) dst[m][k] = *(const PG8_LAS bf16x8*)(lds + PG8_SA(b, h) + aoff + m * 2048 + k * 1024); } while (0)
#define PG8_LDB(dst, b, h) do { _Pragma("unroll") for (int n = 0; n < 2; ++n) _Pragma("unroll") for (int k = 0; k < 2; ++k) dst[n][k] = *(const PG8_LAS bf16x8*)(lds + PG8_SB(b, h) + boff + n * 2048 + k * 1024); } while (0)
#define PG8_MMA(ai, bj, At, Bt) do { __builtin_amdgcn_s_setprio(1); _Pragma("unroll") for (int m = 0; m < 4; ++m) _Pragma("unroll") for (int n = 0; n < 2; ++n) _Pragma("unroll") for (int k = 0; k < 2; ++k) \
        acc[ai][bj][m][n] = __builtin_amdgcn_mfma_f32_16x16x32_bf16(Bt[n][k], At[m][k], acc[ai][bj][m][n], 0, 0, 0); __builtin_amdgcn_s_setprio(0); } while (0)
#define PG8_WAIT_V(n) asm volatile("s_waitcnt vmcnt(" #n ")" ::: "memory")
#define PG8_WAIT_L(n) asm volatile("s_waitcnt lgkmcnt(" #n ")" ::: "memory")
#define PG8_BAR __builtin_amdgcn_s_barrier()
#define PG8_SCHED __builtin_amdgcn_sched_barrier(0)
    Unit cur, nxt; int ui = 0;
    if (!S.next(0, cur)) return;
    f32x4 acc[2][2][4][2];
#pragma unroll
    for (int a = 0; a < 2; ++a)
#pragma unroll
        for (int b = 0; b < 2; ++b)
#pragma unroll
            for (int m = 0; m < 4; ++m)
#pragma unroll
                for (int n = 0; n < 2; ++n) acc[a][b][m][n] = (f32x4){0.f, 0.f, 0.f, 0.f};
    bf16x8 At[4][2], B0[2][2], B1[2][2];
    const char* cA = (const char*)g.A + (size_t)cur.pm * tstep; const char* cB = (const char*)g.Bt + (size_t)cur.pn * tstep;
    S.a_ready(cur);
    if constexpr (SP2) {
        PG8_STAGE(PG8_SB(0, 0), cB, voffB); PG8_STAGE(PG8_SB(0, 1), cB + hstep, voffB); PG8_STAGE(PG8_SA(0, 0), cA, voffA); PG8_STAGE(PG8_SA(0, 1), cA + hstep, voffA);
        if (wr == 1) PG8_BAR;
        PG8_WAIT_V(2); PG8_BAR;
        PG8_STAGE(PG8_SB(1, 0), cB + kstep, voffB); PG8_STAGE(PG8_SA(1, 0), cA + kstep, voffA); PG8_STAGE(PG8_SB(1, 1), cB + hstep + kstep, voffB);
        PG8_WAIT_V(6); PG8_BAR;
    } else {
        PG8_STAGE(PG8_SB(0, 0), cB, voffB); PG8_STAGE(PG8_SA(0, 0), cA, voffA); PG8_STAGE(PG8_SB(0, 1), cB + hstep, voffB); PG8_STAGE(PG8_SA(0, 1), cA + hstep, voffA);
        if (wr == 1) PG8_BAR;
        PG8_WAIT_V(4); PG8_BAR;
        PG8_STAGE(PG8_SB(1, 0), cB + kstep, voffB); PG8_STAGE(PG8_SA(1, 0), cA + kstep, voffA); PG8_STAGE(PG8_SB(1, 1), cB + hstep + kstep, voffB);
        PG8_WAIT_V(6); PG8_BAR;
    }
    for (;;) {
        const bool has_next = S.next(ui + 1, nxt);
        const char* nA = has_next ? (const char*)g.A + (size_t)nxt.pm * tstep : cA; const char* nB = has_next ? (const char*)g.Bt + (size_t)nxt.pn * tstep : cB;
        for (int t = 0; t < nt; t += 2) {
            const bool last = (t == nt - 2);
            const char* a1 = cA + (size_t)(t + 1) * kstep;
            const char* a2 = last ? nA : cA + (size_t)(t + 2) * kstep; const char* b2 = last ? nB : cB + (size_t)(t + 2) * kstep;
            const char* a3 = a2 + kstep; const char* b3 = b2 + kstep;
            if (last && has_next) S.a_ready(nxt);
            if constexpr (SP2) {
            PG8_LDB(B0, 0, 0); PG8_LDB(B1, 0, 1); PG8_SCHED; PG8_LDA(At, 0, 0); PG8_STAGE(PG8_SA(1, 1), a1 + hstep, voffA);
            PG8_WAIT_V(8); PG8_WAIT_L(0); PG8_BAR; PG8_MMA(0, 0, At, B0); PG8_MMA(0, 1, At, B1); PG8_BAR; PG8_SCHED;
            PG8_LDA(At, 0, 1); PG8_STAGE(PG8_SB(0, 0), b2, voffB); PG8_STAGE(PG8_SB(0, 1), b2 + hstep, voffB); PG8_STAGE(PG8_SA(0, 0), a2, voffA);
            PG8_WAIT_V(8); PG8_WAIT_L(0); PG8_BAR; PG8_MMA(1, 0, At, B0); PG8_MMA(1, 1, At, B1); PG8_BAR; PG8_SCHED;
            PG8_LDB(B0, 1, 0); PG8_LDB(B1, 1, 1); PG8_SCHED; PG8_LDA(At, 1, 0); PG8_STAGE(PG8_SA(0, 1), a2 + hstep, voffA);
            PG8_WAIT_V(8); PG8_WAIT_L(0); PG8_BAR; PG8_MMA(0, 0, At, B0); PG8_MMA(0, 1, At, B1); PG8_BAR; PG8_SCHED;
            PG8_LDA(At, 1, 1); PG8_STAGE(PG8_SB(1, 0), b3, voffB); PG8_STAGE(PG8_SB(1, 1), b3 + hstep, voffB); PG8_STAGE(PG8_SA(1, 0), a3, voffA);
            PG8_WAIT_V(8); PG8_WAIT_L(0); PG8_BAR; PG8_MMA(1, 0, At, B0); PG8_MMA(1, 1, At, B1); PG8_BAR; PG8_SCHED;
            } else {
            PG8_LDB(B0, 0, 0); PG8_SCHED; PG8_LDA(At, 0, 0); PG8_STAGE(PG8_SA(1, 1), a1 + hstep, voffA);
            PG8_WAIT_L(8); PG8_BAR; PG8_WAIT_L(0); PG8_MMA(0, 0, At, B0); PG8_BAR; PG8_SCHED;
            PG8_LDB(B1, 0, 1); PG8_STAGE(PG8_SB(0, 0), b2, voffB);
            PG8_BAR; PG8_WAIT_L(0); PG8_MMA(0, 1, At, B1); PG8_BAR;
            PG8_LDA(At, 0, 1); PG8_STAGE(PG8_SA(0, 0), a2, voffA);
            PG8_BAR; PG8_WAIT_L(0); PG8_MMA(1, 0, At, B0); PG8_BAR; PG8_SCHED;
            PG8_STAGE(PG8_SB(0, 1), b2 + hstep, voffB);
            PG8_WAIT_V(6); PG8_BAR; PG8_MMA(1, 1, At, B1); PG8_BAR;
            PG8_LDB(B0, 1, 0); PG8_SCHED; PG8_LDA(At, 1, 0); PG8_STAGE(PG8_SA(0, 1), a2 + hstep, voffA);
            PG8_WAIT_L(8); PG8_BAR; PG8_WAIT_L(0); PG8_MMA(0, 0, At, B0); PG8_BAR; PG8_SCHED;
            PG8_LDB(B1, 1, 1); PG8_STAGE(PG8_SB(1, 0), b3, voffB);
            PG8_BAR; PG8_WAIT_L(0); PG8_MMA(0, 1, At, B1); PG8_BAR;
            PG8_LDA(At, 1, 1); PG8_STAGE(PG8_SA(1, 0), a3, voffA);
            PG8_BAR; PG8_WAIT_L(0); PG8_MMA(1, 0, At, B0); PG8_BAR; PG8_SCHED;
            PG8_STAGE(PG8_SB(1, 1), b3 + hstep, voffB);
            PG8_WAIT_V(6); PG8_BAR; PG8_MMA(1, 1, At, B1); PG8_BAR;
            }
        }
        if constexpr (ALIGN_EPI) { if (wr == 0) PG8_BAR; }
        if constexpr (!Epi::AFTER_DRAIN) { E(acc, cur, wr, wc, fr, fq); S.done(cur); }
        if (!has_next) break;
#pragma unroll
        for (int a = 0; a < 2; ++a)
#pragma unroll
            for (int b = 0; b < 2; ++b)
#pragma unroll
                for (int m = 0; m < 4; ++m)
#pragma unroll
                    for (int n = 0; n < 2; ++n) acc[a][b][m][n] = (f32x4){0.f, 0.f, 0.f, 0.f};
        cur = nxt; cA = nA; cB = nB; ++ui;
        if constexpr (ALIGN_EPI) { if (wr == 1) PG8_BAR; }
    }
    PG8_WAIT_V(0);
    if constexpr (!ALIGN_EPI) { if (wr == 0) PG8_BAR; }
    PG8_BAR;
    if constexpr (Epi::AFTER_DRAIN) { E.fused(acc, cur, wr, wc, fr, fq, lds, wid, lane); S.done(cur); }
#undef PG8_SA
#undef PG8_SB
#undef PG8_STAGE
#undef PG8_LDA
#undef PG8_LDB
#undef PG8_MMA
#undef PG8_WAIT_V
#undef PG8_WAIT_L
#undef PG8_BAR
#undef PG8_SCHED
}
}

#define LAS __attribute__((address_space(3)))
#define GAS __attribute__((address_space(1)))
typedef unsigned short bf16;
typedef float f32x4 __attribute__((ext_vector_type(4)));
typedef float f32x16 __attribute__((ext_vector_type(16)));
typedef short bf16x8 __attribute__((ext_vector_type(8)));
typedef short s16x4 __attribute__((ext_vector_type(4)));
typedef unsigned u32x4 __attribute__((ext_vector_type(4)));
typedef unsigned u32x2 __attribute__((ext_vector_type(2)));

constexpr int DM = 1024, NP = 65536, NS = 128, NTOK = NP + NS, MPAD = 65792;
constexpr int SEQ = 8192, PAST = 4096, DSEQ = 16, SKEYS = PAST + DSEQ;
constexpr int KROWS = NP + 8 * SKEYS, KPAD = 98560;
constexpr int DFF = 2816, NGU = 2 * DFF, NIN = 2216, NINP = 2304, QLORA = 384, KVLORA = 256, NQ = 768, NKV = 1024;
constexpr int C_CKV = 384, C_KR = 640, C_FQ = 672, C_FK = 1184, C_FV = 1696, C_FG = 2208;
constexpr float EPS = 1e-6f, LOG2E = 1.4426950408889634f;

constexpr size_t O_Y = 0, O_CKVP = (size_t)NTOK * DM, O_KRP = O_CKVP + (size_t)NP * 256, O_FKP = O_KRP + (size_t)NP * 32, O_FVP = O_FKP + (size_t)NP * 512,
                 O_LFP = O_FVP + (size_t)NP * 512, O_CKVS = O_LFP + (size_t)NP * 8, O_KRS = O_CKVS + (size_t)NS * 256, O_FKS = O_KRS + (size_t)NS * 32,
                 O_FVS = O_FKS + (size_t)NS * 512, O_LFS = O_FVS + (size_t)NS * 512, O_END = O_LFS + (size_t)NS * 8;

constexpr size_t al256(size_t x) { return (x + 255) & ~(size_t)255; }
constexpr size_t WS_WGU1 = 0, WS_WD1 = WS_WGU1 + al256((size_t)NGU * DM * 2), WS_WGU2 = WS_WD1 + al256((size_t)DM * DFF * 2), WS_WD2 = WS_WGU2 + al256((size_t)NGU * DM * 2),
                 WS_WIN = WS_WD2 + al256((size_t)DM * DFF * 2), WS_WQ = WS_WIN + al256((size_t)NINP * DM * 2), WS_WKV = WS_WQ + al256((size_t)NQ * QLORA * 2),
                 WS_WO = WS_WKV + al256((size_t)NKV * KVLORA * 2), WS_TAB = WS_WO + al256((size_t)DM * DM * 2), WS_LK = WS_TAB + al256((size_t)SEQ * 16 * 8),
                 WS_LFS = WS_LK + al256((size_t)KPAD * 8 * 4), WS_KROPE = WS_LFS + al256((size_t)8 * SKEYS * 8 * 4), WS_XN = WS_KROPE + al256((size_t)KPAD * 32 * 2),
                 WS_D = WS_XN + al256((size_t)MPAD * DM * 2), WS_ACT = WS_D + al256((size_t)MPAD * DM * 2), WS_QM = WS_ACT + al256((size_t)MPAD * DFF * 2),
                 WS_KV = WS_QM + al256((size_t)MPAD * NQ * 2), WS_QCTR = WS_KV + al256((size_t)KPAD * NKV * 2), WS_BAR = WS_QCTR + 4096, WS_END = WS_BAR + 16384;
constexpr size_t WS_PROJ = WS_ACT, WS_CQN = WS_PROJ + al256((size_t)MPAD * NINP * 2);
constexpr size_t WS_CKVN = WS_D, WS_FKS = WS_CKVN + al256((size_t)KPAD * KVLORA * 2), WS_FVS = WS_FKS + al256((size_t)(8 * SKEYS + 64) * 512 * 2);
static_assert(WS_CQN + (size_t)MPAD * QLORA * 2 <= WS_QM, "overlay 1");
static_assert(WS_FVS + (size_t)(8 * SKEYS + 64) * 512 * 2 <= WS_ACT, "overlay 2");

constexpr int LDS_BYTES = 135168;

struct Args { const float* in[24]; float* out; unsigned char* ws; };
constexpr int PTR_OFF = 131072;
struct Ctx {
    LAS unsigned char* lds;
    __device__ __forceinline__ unsigned long long raw(int i) const { const unsigned long long v = *(const LAS unsigned long long*)(lds + PTR_OFF + 8 * i);
        const unsigned lo = __builtin_amdgcn_readfirstlane((unsigned)v), hi = __builtin_amdgcn_readfirstlane((unsigned)(v >> 32)); return ((unsigned long long)hi << 32) | lo; }
    __device__ __forceinline__ const float* in(int i) const { return (const float*)raw(i); }
    __device__ __forceinline__ float* out() const { return (float*)raw(24); }
    __device__ __forceinline__ unsigned char* ws() const { return (unsigned char*)raw(25); }
};
enum { I_XP = 0, I_XS, I_CCKV, I_CKR, I_CFK, I_CFV, I_CLF, I_G1PRE, I_G1POST, I_W1GU, I_W1D, I_GMPRE, I_GMPOST, I_WIN, I_BF, I_GQ, I_WQ, I_GKV, I_WKV, I_WO, I_G2PRE, I_G2POST, I_W2GU, I_W2D };

__device__ __forceinline__ unsigned f2bf(float f) { unsigned u = __builtin_bit_cast(unsigned, f); return (u + 0x7fffu + ((u >> 16) & 1u)) >> 16; }
__device__ __forceinline__ unsigned pk2(float lo, float hi) { return pg8::cvt_pk_bf16(lo, hi); }
__device__ __forceinline__ float bf2f(unsigned short b) { return __builtin_bit_cast(float, (unsigned)b << 16); }
__device__ __forceinline__ float bflo(unsigned w) { return __builtin_bit_cast(float, w << 16); }
__device__ __forceinline__ float bfhi(unsigned w) { return __builtin_bit_cast(float, w & 0xffff0000u); }
__device__ __forceinline__ float wave_sum(float v) {
#pragma unroll
    for (int o = 1; o < 64; o <<= 1) v += __shfl_xor(v, o);
    return v;
}
__device__ __forceinline__ int keyrow(int n) { return n < NP ? n : NP + ((n - NP) >> 4) * SKEYS + PAST + ((n - NP) & 15); }
__device__ __forceinline__ int rowpos(int n) { return n < NP ? (n & (SEQ - 1)) : PAST + ((n - NP) & 15); }

struct MapId  { __device__ __forceinline__ int col(int c) const { return c; } };
struct MapGU  { __device__ __forceinline__ int col(int c) const { return ((c >> 7) & 1) * DFF + (c >> 8) * 128 + (c & 127); } };
struct MapIn  { __device__ __forceinline__ int col(int c) const { return c < NIN ? c : -1; } };
struct MapQ   { __device__ __forceinline__ int col(int c) const { const int h = c / 96, w = c % 96; if (w < 64) return c; const int p = w - 64; return h * 96 + 64 + ((p & 1) ? (p >> 1) + 16 : (p >> 1)); } };
template <class Map> __device__ __forceinline__ void transpose_w(const float* W, int K, int Nsrc, bf16* WT, int Ndst, Map map, LAS float* scr, int gw, int NGW, int lane) {
    const int nblk = Ndst / 32, items = (K / 64) * nblk;
    for (int it = gw; it < items; it += NGW) {
        const int kb = it / nblk, nb = it % nblk, k0 = 64 * kb, n0 = 32 * nb;
        const int sc = map.col(n0 + (lane & 31));
#pragma unroll 8
        for (int i = 0; i < 32; ++i) { const int kk = 2 * i + (lane >> 5); scr[kk * 33 + (lane & 31)] = sc >= 0 ? W[(size_t)(k0 + kk) * Nsrc + sc] : 0.f; }
        asm volatile("s_waitcnt lgkmcnt(0)" ::: "memory");
        const int c = lane & 7;
#pragma unroll
        for (int j = 0; j < 4; ++j) { const int n = (lane >> 3) + 8 * j; const LAS float* s = scr + (8 * c) * 33 + n;
            u32x4 o; o.x = pk2(s[0 * 33], s[1 * 33]); o.y = pk2(s[2 * 33], s[3 * 33]); o.z = pk2(s[4 * 33], s[5 * 33]); o.w = pk2(s[6 * 33], s[7 * 33]);
            *(u32x4*)(WT + (size_t)(n0 + n) * K + k0 + 8 * c) = o; }
        asm volatile("s_waitcnt lgkmcnt(0)" ::: "memory");
    }
}
template <class Map> __device__ __forceinline__ void transpose_w4(const float* W, int K, int Nsrc, bf16* WT, int Ndst, Map map, LAS float* scr, int gw, int NGW, int lane) {
    const int nblk = Ndst / 32, items = (K / 64) * nblk;
    const int kq = lane >> 3, c4 = lane & 7;
    for (int it = gw; it < items; it += NGW) {
        const int kb = it / nblk, nb = it % nblk, k0 = 64 * kb, n0 = 32 * nb;
        const float* src = W + (size_t)(k0 + kq) * Nsrc + map.col(n0) + 4 * c4;
        f32x4 v[8];
#pragma unroll
        for (int i = 0; i < 8; ++i) v[i] = *(const GAS f32x4*)(src + (size_t)(8 * i) * Nsrc);
#pragma unroll
        for (int i = 0; i < 8; ++i) { LAS float* d = scr + (8 * i + kq) * 33 + 4 * c4; d[0] = v[i][0]; d[1] = v[i][1]; d[2] = v[i][2]; d[3] = v[i][3]; }
        asm volatile("s_waitcnt lgkmcnt(0)" ::: "memory");
        const int c = lane & 7;
#pragma unroll
        for (int j = 0; j < 4; ++j) { const int n = (lane >> 3) + 8 * j; const LAS float* s = scr + (8 * c) * 33 + n;
            u32x4 o; o.x = pk2(s[0 * 33], s[1 * 33]); o.y = pk2(s[2 * 33], s[3 * 33]); o.z = pk2(s[4 * 33], s[5 * 33]); o.w = pk2(s[6 * 33], s[7 * 33]);
            *(GAS u32x4*)(WT + (size_t)(n0 + n) * K + k0 + 8 * c) = o; }
        asm volatile("s_waitcnt lgkmcnt(0)" ::: "memory");
    }
}
__device__ __forceinline__ void rope_cs(int pos, int i, float& c, float& s) {
    double f = 1.0; for (int k = 0; k < i; ++k) f *= 0.56234132519034908;
    const double ang = (double)pos * f;
    const double q = __builtin_rint(ang * 0.63661977236758134);
    const double y = (ang - q * 1.5707963267948966) - q * 6.123233995736766e-17;
    const double y2 = y * y;
    const double sn = y * (1.0 + y2 * (-1.0 / 6 + y2 * (1.0 / 120 + y2 * (-1.0 / 5040 + y2 * (1.0 / 362880 + y2 * (-1.0 / 39916800 + y2 * (1.0 / 6227020800.0)))))));
    const double cs = 1.0 + y2 * (-0.5 + y2 * (1.0 / 24 + y2 * (-1.0 / 720 + y2 * (1.0 / 40320 + y2 * (-1.0 / 3628800 + y2 * (1.0 / 479001600 + y2 * (-1.0 / 87178291200.0)))))));
    const int qi = (int)((long long)q & 3);
    const double cc = (qi == 0) ? cs : (qi == 1) ? -sn : (qi == 2) ? -cs : sn;
    const double ss = (qi == 0) ? sn : (qi == 1) ? cs : (qi == 2) ? -sn : -cs;
    c = (float)cc; s = (float)ss;
}

__device__ __forceinline__ void load16_f32(const float* p, int lane, float (&v)[16]) {
#pragma unroll
    for (int j = 0; j < 2; ++j) { const f32x4 a = *(const f32x4*)(p + 8 * lane + 512 * j), b = *(const f32x4*)(p + 8 * lane + 512 * j + 4);
        v[8 * j + 0] = a[0]; v[8 * j + 1] = a[1]; v[8 * j + 2] = a[2]; v[8 * j + 3] = a[3]; v[8 * j + 4] = b[0]; v[8 * j + 5] = b[1]; v[8 * j + 6] = b[2]; v[8 * j + 7] = b[3]; }
}
__device__ __forceinline__ void load16_bf16(const bf16* p, int lane, float (&v)[16]) {
#pragma unroll
    for (int j = 0; j < 2; ++j) { const u32x4 a = *(const u32x4*)(p + 8 * lane + 512 * j);
        v[8 * j + 0] = bflo(a.x); v[8 * j + 1] = bfhi(a.x); v[8 * j + 2] = bflo(a.y); v[8 * j + 3] = bfhi(a.y); v[8 * j + 4] = bflo(a.z); v[8 * j + 5] = bfhi(a.z); v[8 * j + 6] = bflo(a.w); v[8 * j + 7] = bfhi(a.w); }
}
__device__ __forceinline__ void store16_f32(float* p, int lane, const float (&v)[16]) {
#pragma unroll
    for (int j = 0; j < 2; ++j) { *(f32x4*)(p + 8 * lane + 512 * j) = (f32x4){v[8 * j], v[8 * j + 1], v[8 * j + 2], v[8 * j + 3]}; *(f32x4*)(p + 8 * lane + 512 * j + 4) = (f32x4){v[8 * j + 4], v[8 * j + 5], v[8 * j + 6], v[8 * j + 7]}; }
}
__device__ __forceinline__ void store16_f32_nt(float* p, int lane, const float (&v)[16]) {
#pragma unroll
    for (int j = 0; j < 2; ++j) { __builtin_nontemporal_store((f32x4){v[8 * j], v[8 * j + 1], v[8 * j + 2], v[8 * j + 3]}, (f32x4*)(p + 8 * lane + 512 * j)); __builtin_nontemporal_store((f32x4){v[8 * j + 4], v[8 * j + 5], v[8 * j + 6], v[8 * j + 7]}, (f32x4*)(p + 8 * lane + 512 * j + 4)); }
}
__device__ __forceinline__ void store16_bf16(bf16* p, int lane, const float (&v)[16]) {
#pragma unroll
    for (int j = 0; j < 2; ++j) { u32x4 o; o.x = pk2(v[8 * j], v[8 * j + 1]); o.y = pk2(v[8 * j + 2], v[8 * j + 3]); o.z = pk2(v[8 * j + 4], v[8 * j + 5]); o.w = pk2(v[8 * j + 6], v[8 * j + 7]); *(u32x4*)(p + 8 * lane + 512 * j) = o; }
}
__device__ __forceinline__ float ssq16(const float (&v)[16]) { float s = 0.f;
#pragma unroll
    for (int i = 0; i < 16; ++i) s += v[i] * v[i];
    return wave_sum(s); }
__device__ __forceinline__ void rp_norm_only(const Ctx& a, const float* g, bf16* XN, int gw, int NGW, int lane) {
    float gv[16]; load16_f32(g, lane, gv); const float* xp = a.in(I_XP); const float* xs = a.in(I_XS);
    for (int n = gw; n < NTOK; n += NGW) {
        const float* xr = n < NP ? xp + (size_t)n * DM : xs + (size_t)(n - NP) * DM;
        float v[16]; load16_f32(xr, lane, v);
        const float rs = 1.0f / sqrtf(ssq16(v) * (1.0f / DM) + EPS);
#pragma unroll
        for (int i = 0; i < 16; ++i) v[i] = v[i] * rs * gv[i];
        store16_bf16(XN + (size_t)n * DM, lane, v);
    }
}
__device__ __forceinline__ void rp_residual(const Ctx& a, bool base_is_x, bool final_y, const bf16* D, float coef, const float* gpost, const float* gnext, float* hout, bf16* XN, int n0, int n1, int gw, int NGW, int lane) {
    const float* xp = a.in(I_XP); const float* xs = a.in(I_XS);
    float g[16], g2[16]; load16_f32(gpost, lane, g); if (gnext) load16_f32(gnext, lane, g2);
    for (int n = n0 + gw; n < n1; n += NGW) {
        float v[16], d[16];
        if (base_is_x) load16_f32(n < NP ? xp + (size_t)n * DM : xs + (size_t)(n - NP) * DM, lane, v); else load16_bf16((const bf16*)(hout + (size_t)n * DM), lane, v);
        load16_bf16(D + (size_t)n * DM, lane, d);
        const float rs = coef / sqrtf(ssq16(d) * (1.0f / DM) + EPS);
#pragma unroll
        for (int i = 0; i < 16; ++i) v[i] = v[i] + d[i] * rs * g[i];
        if (final_y) store16_f32_nt(hout + (size_t)n * DM, lane, v); else store16_bf16((bf16*)(hout + (size_t)n * DM), lane, v);
        if (gnext) {
            const float rs2 = 1.0f / sqrtf(ssq16(v) * (1.0f / DM) + EPS);
#pragma unroll
            for (int i = 0; i < 16; ++i) v[i] = v[i] * rs2 * g2[i];
            store16_bf16(XN + (size_t)n * DM, lane, v);
        }
    }
}
__device__ __forceinline__ void rp_mix(const Ctx& a, int n0, int n1, bool do_cache, int gw, int NGW, int lane) {
    unsigned char* ws = a.ws(); float* out = a.out();
    const bf16* PROJ = (const bf16*)(ws + WS_PROJ); bf16* CQN = (bf16*)(ws + WS_CQN); bf16* CKVN = (bf16*)(ws + WS_CKVN); bf16* KROPE = (bf16*)(ws + WS_KROPE);
    bf16* FKS = (bf16*)(ws + WS_FKS); bf16* FVS = (bf16*)(ws + WS_FVS); float* LFS = (float*)(ws + WS_LFS); const float* TAB = (const float*)(ws + WS_TAB);
    const float* gq = a.in(I_GQ); const float* gkv = a.in(I_GKV); const float* bfg = a.in(I_BF);
    for (int n = n0 + gw; n < n1; n += NGW) {
        const bf16* pr = PROJ + (size_t)n * NINP; const bool smp = n >= NP; const int ns = n - NP; const int kr = keyrow(n);
        { const unsigned* p = (const unsigned*)(pr + 6 * lane); const unsigned w0 = p[0], w1 = p[1], w2 = p[2];
          float v[6] = {bflo(w0), bfhi(w0), bflo(w1), bfhi(w1), bflo(w2), bfhi(w2)}; float s = 0.f;
#pragma unroll
          for (int i = 0; i < 6; ++i) s += v[i] * v[i];
          const float rs = 1.0f / sqrtf(wave_sum(s) * (1.0f / QLORA) + EPS);
#pragma unroll
          for (int i = 0; i < 6; ++i) v[i] = v[i] * rs * gq[6 * lane + i];
          unsigned* o = (unsigned*)(CQN + (size_t)n * QLORA + 6 * lane); o[0] = pk2(v[0], v[1]); o[1] = pk2(v[2], v[3]); o[2] = pk2(v[4], v[5]); }
        { const u32x2 w = *(const u32x2*)(pr + C_CKV + 4 * lane); float v[4] = {bflo(w.x), bfhi(w.x), bflo(w.y), bfhi(w.y)};
          const float rs = 1.0f / sqrtf(wave_sum(v[0] * v[0] + v[1] * v[1] + v[2] * v[2] + v[3] * v[3]) * (1.0f / KVLORA) + EPS);
          const f32x4 g = *(const f32x4*)(gkv + 4 * lane); const f32x4 r = {v[0] * rs * g[0], v[1] * rs * g[1], v[2] * rs * g[2], v[3] * rs * g[3]};
          __builtin_nontemporal_store(r, (f32x4*)(out + (smp ? O_CKVS + (size_t)ns * 256 : O_CKVP + (size_t)n * 256) + 4 * lane));
          u32x2 o; o.x = pk2(r[0], r[1]); o.y = pk2(r[2], r[3]); *(u32x2*)(CKVN + (size_t)kr * KVLORA + 4 * lane) = o; }
        if (lane < 16) { const float x1 = bf2f(pr[C_KR + lane]), x2 = bf2f(pr[C_KR + 16 + lane]); const int pos = rowpos(n);
          const float c = TAB[((size_t)pos * 16 + lane) * 2], s = TAB[((size_t)pos * 16 + lane) * 2 + 1];
          const float o1 = x1 * c - x2 * s, o2 = x1 * s + x2 * c; float* kr_out = out + (smp ? O_KRS + (size_t)ns * 32 : O_KRP + (size_t)n * 32);
          kr_out[lane] = o1; kr_out[16 + lane] = o2; *(unsigned*)(KROPE + (size_t)kr * 32 + 2 * lane) = pk2(o1, o2); }
        { const u32x4 wk = *(const u32x4*)(pr + C_FK + 8 * lane), wv = *(const u32x4*)(pr + C_FV + 8 * lane);
          float* ko = out + (smp ? O_FKS + (size_t)ns * 512 : O_FKP + (size_t)n * 512) + 8 * lane; float* vo = out + (smp ? O_FVS + (size_t)ns * 512 : O_FVP + (size_t)n * 512) + 8 * lane;
          __builtin_nontemporal_store((f32x4){bflo(wk.x), bfhi(wk.x), bflo(wk.y), bfhi(wk.y)}, (f32x4*)ko); __builtin_nontemporal_store((f32x4){bflo(wk.z), bfhi(wk.z), bflo(wk.w), bfhi(wk.w)}, (f32x4*)(ko + 4));
          __builtin_nontemporal_store((f32x4){bflo(wv.x), bfhi(wv.x), bflo(wv.y), bfhi(wv.y)}, (f32x4*)vo); __builtin_nontemporal_store((f32x4){bflo(wv.z), bfhi(wv.z), bflo(wv.w), bfhi(wv.w)}, (f32x4*)(vo + 4));
          if (smp) { *(u32x4*)(FKS + (size_t)(kr - NP) * 512 + 8 * lane) = wk; *(u32x4*)(FVS + (size_t)(kr - NP) * 512 + 8 * lane) = wv; } }
        if (lane < 8) { const float z = bf2f(pr[C_FG + lane]) + bfg[lane]; const float lf = fminf(z, 0.f) - log1pf(expf(-fabsf(z)));
          out[(smp ? O_LFS + (size_t)ns * 8 : O_LFP + (size_t)n * 8) + lane] = lf; if (smp) LFS[(size_t)(kr - NP) * 8 + lane] = lf; }
    }
    if (!do_cache) return;
    int lane_ = lane; asm volatile("" : "+v"(lane_));
    const unsigned gt = (unsigned)gw * 64u + (unsigned)lane_, NT = (unsigned)NGW * 64u;
    { const float* src = a.in(I_CCKV);
      for (unsigned e = gt; e < 8u * PAST * 256 / 8; e += NT) { const unsigned row = e >> 5, c = (e & 31) * 8; const unsigned b = row >> 12, j = row & 4095;
        const f32x4 x = *(const f32x4*)(src + (size_t)row * 256 + c), y = *(const f32x4*)(src + (size_t)row * 256 + c + 4);
        u32x4 o; o.x = pk2(x[0], x[1]); o.y = pk2(x[2], x[3]); o.z = pk2(y[0], y[1]); o.w = pk2(y[2], y[3]); *(u32x4*)(CKVN + ((size_t)NP + b * SKEYS + j) * 256 + c) = o; } }
    { const float* srck = a.in(I_CFK); const float* srcv = a.in(I_CFV);
      for (unsigned e = gt; e < 8u * PAST * 512 / 8; e += NT) { const unsigned row = e >> 6, c = (e & 63) * 8; const unsigned b = row >> 12, j = row & 4095;
        f32x4 x = *(const f32x4*)(srck + (size_t)row * 512 + c), y = *(const f32x4*)(srck + (size_t)row * 512 + c + 4);
        u32x4 o; o.x = pk2(x[0], x[1]); o.y = pk2(x[2], x[3]); o.z = pk2(y[0], y[1]); o.w = pk2(y[2], y[3]); *(u32x4*)(FKS + (size_t)(b * SKEYS + j) * 512 + c) = o;
        x = *(const f32x4*)(srcv + (size_t)row * 512 + c); y = *(const f32x4*)(srcv + (size_t)row * 512 + c + 4);
        o.x = pk2(x[0], x[1]); o.y = pk2(x[2], x[3]); o.z = pk2(y[0], y[1]); o.w = pk2(y[2], y[3]); *(u32x4*)(FVS + (size_t)(b * SKEYS + j) * 512 + c) = o; } }
    { const float* src = a.in(I_CKR);
      for (unsigned e = gt; e < 8u * PAST * 16; e += NT) { const unsigned row = e >> 4, i = e & 15; const unsigned b = row >> 12, j = row & 4095;
        *(unsigned*)(KROPE + ((size_t)NP + b * SKEYS + j) * 32 + 2 * i) = pk2(src[(size_t)row * 32 + i], src[(size_t)row * 32 + 16 + i]); } }
    { const float* src = a.in(I_CLF);
      for (unsigned e = gt; e < 8u * PAST * 8; e += NT) { const unsigned row = e >> 3, h = e & 7; const unsigned b = row >> 12, j = row & 4095; LFS[(size_t)(b * SKEYS + j) * 8 + h] = src[e]; } }
}
__device__ __forceinline__ void scan_item(const float* src, float* dst, int len, LAS float* sm, int tid) {
    const int per = (len + 511) / 512, i0 = tid * per, i1 = min(len, i0 + per);
    float s = 0.f; for (int i = i0; i < i1; ++i) s += src[(size_t)i * 8];
    const int lane = tid & 63, wid = tid >> 6; float inc = s;
#pragma unroll
    for (int o = 1; o < 64; o <<= 1) { const float t = __shfl_up(inc, o); if (lane >= o) inc += t; }
    __syncthreads();
    if (lane == 63) sm[wid] = inc;
    __syncthreads();
    float pre = 0.f; for (int w = 0; w < wid; ++w) pre += sm[w];
    float run = pre + inc - s;
    for (int i = i0; i < i1; ++i) { run += src[(size_t)i * 8]; dst[(size_t)i * 8] = run; }
}

struct AttnUnit { const bf16* Q; const bf16* K; const bf16* KR; const bf16* V; const float* LK; const float* TAB; bf16* O; int qpitch, kpitch, vpitch, nkeys, qpos0, nq; };
constexpr int A_KP = 208, A_VP = 192, A_KB = 64 * A_KP, A_VB = 64 * A_VP, A_STG = A_KB + A_VB + 256, A_WS = 2 * A_STG;
__device__ __forceinline__ int crow(int r, int hi) { return (r & 3) + 8 * (r >> 2) + 4 * hi; }
typedef float f32x2_t __attribute__((ext_vector_type(2))); typedef __bf16 bf16x2_t __attribute__((ext_vector_type(2)));
__device__ __forceinline__ unsigned cvtpk(float lo, float hi) { f32x2_t v = {lo, hi}; bf16x2_t b = __builtin_convertvector(v, bf16x2_t); return __builtin_bit_cast(unsigned, b); }
#define MX3(a, b, c) __builtin_fmaxf(__builtin_fmaxf((a), (b)), (c))
template <int TYPE> __device__ __forceinline__ void attn_unit(LAS unsigned char* lds, const AttnUnit& U) {
    constexpr int ND = TYPE == 0 ? 6 : 4;
    constexpr float SC = (TYPE == 0 ? 0.10206207261596575f : 0.125f) * LOG2E;
    constexpr float THR = 40.0f;
    int tid_ = threadIdx.x; asm volatile("" : "+v"(tid_));
    const int tid = tid_, lane = tid & 63, wid = __builtin_amdgcn_readfirstlane(tid >> 6), r32 = lane & 31, hi = lane >> 5;
    const int NT = (U.qpos0 + (U.nq > 32 ? 256 : 32) - 1) / 64 + 1;
    const bool active = wid * 32 < U.nq;
    const int NTw = active ? (U.qpos0 + 32 * wid + 31) / 64 + 1 : 0;
    LAS float* wsf = (LAS float*)(lds + 82944) + wid * 64;
#define A_KS(s) ((s) * 12288)
#define A_VS(s) (49152 + (s) * 8192)
#define A_BS(s) (81920 + (s) * 256)
    const unsigned lds0 = (unsigned)(uintptr_t)lds;
    const int lastrow = U.nkeys - 1 - 64 * (NT - 1);
    const int lr8 = 8 * wid + (lane >> 3);
    const int kch = (lane & 7) ^ ((4 * wid + (lane >> 4)) & 7);
    const int vch = (lane & 7) ^ (((lane >> 4) & 1) * 4);
    const int rr16 = 16 * (wid & 3) + (lane >> 2), rch = (lane & 3) ^ ((lane >> 4) & 3);
    const unsigned voK = (unsigned)(lr8 * U.kpitch * 2 + 16 * kch), voKl = (unsigned)(min(lr8, lastrow) * U.kpitch * 2 + 16 * kch);
    const unsigned voV = (unsigned)(lr8 * U.vpitch * 2 + 16 * vch), voVl = (unsigned)(min(lr8, lastrow) * U.vpitch * 2 + 16 * vch);
    const unsigned voA = TYPE == 0 ? (unsigned)(rr16 * 64 + 16 * rch) : (unsigned)(lane * 32), voAl = TYPE == 0 ? (unsigned)(min(rr16, lastrow) * 64 + 16 * rch) : (unsigned)(min(lane, lastrow) * 32);
#define A_DMA16(vo, sb, dst) do { unsigned keep_; asm volatile("s_mov_b32 %0, m0\n\ts_mov_b32 m0, %3\n\ts_nop 0\n\tglobal_load_lds_dwordx4 %1, %2\n\ts_mov_b32 m0, %0" : "=&s"(keep_) : "v"(vo), "s"(sb), "s"(dst) : "memory"); } while (0)
#define A_DMA4(vo, sb, dst) do { unsigned keep_; asm volatile("s_mov_b32 %0, m0\n\ts_mov_b32 m0, %3\n\ts_nop 0\n\tglobal_load_lds_dword %1, %2\n\ts_mov_b32 m0, %0" : "=&s"(keep_) : "v"(vo), "s"(sb), "s"(dst) : "memory"); } while (0)
#define A_DMAK(t, slot) do { const int tc_ = min((int)(t), NT - 1); const bool l_ = tc_ == NT - 1; \
        const bf16* kb_ = U.K + (size_t)(64 * tc_) * U.kpitch; \
        A_DMA16(l_ ? voKl : voK, kb_, (unsigned)__builtin_amdgcn_readfirstlane(lds0 + A_KS(slot) + wid * 1024)); \
        if (TYPE == 0) { const bf16* rb_ = U.KR + (size_t)(64 * tc_) * 32; A_DMA16(l_ ? voAl : voA, rb_, (unsigned)__builtin_amdgcn_readfirstlane(lds0 + A_KS(slot) + 8192 + (wid & 3) * 1024)); } \
        else { const float* bb_ = U.LK + (size_t)(64 * tc_) * 8; A_DMA4(l_ ? voAl : voA, bb_, (unsigned)__builtin_amdgcn_readfirstlane(lds0 + A_BS(slot))); } } while (0)
#define A_DMAV(t, slot) do { const int tc_ = min((int)(t), NT - 1); const bool l_ = tc_ == NT - 1; const bf16* vb_ = U.V + (size_t)(64 * tc_) * U.vpitch; \
        A_DMA16(l_ ? voVl : voV, vb_, (unsigned)__builtin_amdgcn_readfirstlane(lds0 + A_VS(slot) + wid * 1024)); } while (0)
#define A_SB() __builtin_amdgcn_sched_barrier(0)
#define A_PINW() asm volatile("" : "+v"(pw[0]), "+v"(pw[1]), "+v"(pw[2]), "+v"(pw[3]))
#define A_PINP() asm volatile("" : "+v"(p0), "+v"(p1))
#define A_PK1(c) do { if ((c) < 16) { const int i_ = 2 * (c); pw[(c) >> 2][(c) & 3] = cvtpk(i_ < 16 ? p0[i_ & 15] : p1[i_ & 15], i_ < 16 ? p0[(i_ + 1) & 15] : p1[(i_ + 1) & 15]); } } while (0)
    unsigned kad[ND];
#pragma unroll
    for (int d0 = 0; d0 < ND; ++d0) kad[d0] = lds0 + (d0 < 4 ? r32 * 128 + 16 * ((2 * d0 + hi) ^ ((r32 >> 1) & 7)) : 8192 + r32 * 64 + 16 * ((2 * (d0 - 4) + hi) ^ ((r32 >> 2) & 3)));
    const int vq_ = (lane & 15) >> 2, vp_ = lane & 3, vsw_ = ((vq_ >> 1) & 1) * 4, vck_ = 2 * ((lane >> 4) & 1) + (vp_ >> 1);
    const unsigned vad0 = lds0 + (4 * hi + vq_) * 128 + 16 * (vck_ ^ vsw_) + 8 * (vp_ & 1), vad1 = lds0 + (4 * hi + vq_) * 128 + 16 * ((4 + vck_) ^ vsw_) + 8 * (vp_ & 1);
    const unsigned bad = lds0 + 16 * hi;
#define A_LDK(d0, half) (*(const LAS bf16x8*)(uintptr_t)(kcur[d0] + (half) * ((d0) < 4 ? 32 * 128 : 32 * 64)))
#define A_QKPRE(SK, s0, s1) \
        unsigned kcur[ND]; \
        _Pragma("unroll") for (int d0 = 0; d0 < ND; ++d0) kcur[d0] = kad[d0] + (unsigned)A_KS(SK); \
        if (TYPE == 1) { const float nm_ = -mref; const unsigned bcur = bad + (unsigned)A_BS(SK); \
            _Pragma("unroll") for (int g = 0; g < 4; ++g) { const f32x4 b0 = *(const LAS f32x4*)(uintptr_t)(bcur + 32 * g), b1 = *(const LAS f32x4*)(uintptr_t)(bcur + 128 + 32 * g); \
                _Pragma("unroll") for (int i = 0; i < 4; ++i) { s0[4 * g + i] = __builtin_fmaf(b0[i], -LOG2E, nm_); s1[4 * g + i] = __builtin_fmaf(b1[i], -LOG2E, nm_); } } \
        } else { s0 = negm; s1 = negm; } \
        bf16x8 ka0 = A_LDK(0, 0), ka1 = A_LDK(0, 1);
#define A_QK(SK, s0, s1, PACK) do { \
        A_SB(); \
        _Pragma("unroll") for (int d0 = 0; d0 < ND; ++d0) { \
            bf16x8 kn0 = ka0, kn1 = ka1; \
            if (d0 + 1 < ND) { kn0 = A_LDK((d0 + 1 < ND ? d0 + 1 : 0), 0); kn1 = A_LDK((d0 + 1 < ND ? d0 + 1 : 0), 1); } \
            s0 = __builtin_amdgcn_mfma_f32_32x32x16_bf16(ka0, qf[d0], s0, 0, 0, 0); \
            if (PACK) { A_PK1(4 * d0); A_PK1(4 * d0 + 1); A_PINW(); } \
            A_SB(); \
            s1 = __builtin_amdgcn_mfma_f32_32x32x16_bf16(ka1, qf[d0], s1, 0, 0, 0); \
            if (PACK) { A_PK1(4 * d0 + 2); A_PK1(4 * d0 + 3); A_PINW(); } \
            A_SB(); \
            ka0 = kn0; ka1 = kn1; } } while (0)
#define A_PACK() do { _Pragma("unroll") for (int c = 0; c < 16; ++c) A_PK1(c); } while (0)
#define A_MASK(t, s0, s1) do { const int qpos = U.qpos0 + 32 * wid + r32; \
        _Pragma("unroll") for (int r = 0; r < 16; ++r) { const int kv = 64 * (t) + crow(r, hi); \
            if (!(kv < U.nkeys && (TYPE == 0 || kv <= qpos))) s0[r] = -INFINITY; \
            if (!(kv + 32 < U.nkeys && (TYPE == 0 || kv + 32 <= qpos))) s1[r] = -INFINITY; } } while (0)
#define A_ROWMAX(s0, s1, mt) do { float ma = MX3(s0[0], s0[1], s1[0]), mb = MX3(s0[2], s0[3], s1[1]); ma = MX3(ma, s1[2], s1[3]); \
        _Pragma("unroll") for (int r = 4; r < 16; r += 4) { ma = MX3(ma, s0[r], s0[r + 1]); mb = MX3(mb, s0[r + 2], s0[r + 3]); ma = MX3(ma, s1[r], s1[r + 1]); mb = MX3(mb, s1[r + 2], s1[r + 3]); } \
        mt = fmaxf(ma, mb); { const auto rr_ = __builtin_amdgcn_permlane32_swap(__float_as_uint(mt), __float_as_uint(mt), false, false); mt = fmaxf(__uint_as_float(rr_[0]), __uint_as_float(rr_[1])); } } while (0)
#define A_TR(a) __builtin_bit_cast(s16x4, __builtin_amdgcn_ds_read_tr16_b64_v4i16((LAS s16x4*)(uintptr_t)(a)))
#define A_VRD(dst0, dst1, kk_, SV) do { const int kvb_ = 32 * ((kk_) >> 1) + 16 * ((kk_) & 1); \
        const s16x4 l0_ = A_TR(vcur0 + kvb_ * 128), h0_ = A_TR(vcur0 + (kvb_ + 8) * 128), l1_ = A_TR(vcur1 + kvb_ * 128), h1_ = A_TR(vcur1 + (kvb_ + 8) * 128); \
        dst0 = (bf16x8){l0_[0], l0_[1], l0_[2], l0_[3], h0_[0], h0_[1], h0_[2], h0_[3]}; dst1 = (bf16x8){l1_[0], l1_[1], l1_[2], l1_[3], h1_[0], h1_[1], h1_[2], h1_[3]}; } while (0)
#define A_EX0(r, sv) p0[r] = __builtin_amdgcn_exp2f(sv[r])
#define A_EX1(r, sv) p1[r] = __builtin_amdgcn_exp2f(sv[r])
#define A_PV(SV, EXPS, s0, s1) do { \
        const unsigned vcur0 = vad0 + (unsigned)A_VS(SV), vcur1 = vad1 + (unsigned)A_VS(SV); \
        bf16x8 va0, va1; A_VRD(va0, va1, 0, SV); \
        A_SB(); \
        _Pragma("unroll") for (int kk = 0; kk < 4; ++kk) { \
            const bf16x8 pk_ = __builtin_bit_cast(bf16x8, pw[kk]); \
            bf16x8 vn0 = va0, vn1 = va1; \
            o2 = __builtin_amdgcn_mfma_f32_32x32x16_bf16(pk_, ones, o2, 0, 0, 0); \
            if (EXPS) { A_EX0(4 * kk, s0); A_EX0(4 * kk + 1, s0); A_EX1(4 * kk, s1); A_PINP(); } \
            if (kk + 1 < 4) A_VRD(vn0, vn1, kk + 1, SV); \
            A_SB(); \
            o0 = __builtin_amdgcn_mfma_f32_32x32x16_bf16(pk_, va0, o0, 0, 0, 0); \
            if (EXPS) { A_EX0(4 * kk + 2, s0); A_EX1(4 * kk + 1, s1); A_EX1(4 * kk + 2, s1); A_PINP(); } \
            A_SB(); \
            o1 = __builtin_amdgcn_mfma_f32_32x32x16_bf16(pk_, va1, o1, 0, 0, 0); \
            if (EXPS) { A_EX0(4 * kk + 3, s0); A_EX1(4 * kk + 3, s1); A_PINP(); } \
            A_SB(); \
            va0 = vn0; va1 = vn1; } } while (0)
    float mref = 0.f;
    f32x16 o0 = {}, o1 = {}, o2 = {}, negm = {}, p0 = {}, p1 = {};
    u32x4 pw[4] = {};
    const bf16x8 ones = {0x3F80, 0x3F80, 0x3F80, 0x3F80, 0x3F80, 0x3F80, 0x3F80, 0x3F80};
#define A_WAITBAR(n) asm volatile("s_waitcnt vmcnt(" #n ") lgkmcnt(0)\n\ts_barrier" ::: "memory")
    A_DMAK(0, 0); A_DMAK(1, 1); A_DMAV(0, 0);
    bf16x8 qf[ND];
    { int qrow = wid * 32 + r32; if (qrow >= U.nq) qrow = U.nq - 1;
      const bf16* qp = U.Q + (size_t)qrow * U.qpitch + hi * 8;
#pragma unroll
      for (int d0 = 0; d0 < ND; ++d0) qf[d0] = *(const GAS bf16x8*)(qp + d0 * 16);
#pragma unroll
      for (int d0 = 0; d0 < ND; ++d0) {
          u32x4 w = __builtin_bit_cast(u32x4, qf[d0]);
          if (TYPE == 0 && d0 >= 4) {
              const float* tb = U.TAB + (size_t)(U.qpos0 + qrow) * 32; const int pb = 8 * (d0 - 4) + 4 * hi; const f32x4 t0 = *(const GAS f32x4*)(tb + 2 * pb), t1 = *(const GAS f32x4*)(tb + 2 * pb + 4);
              { const float x1 = bflo(w.x), x2 = bfhi(w.x); w.x = cvtpk((x1 * t0[0] - x2 * t0[1]) * SC, (x1 * t0[1] + x2 * t0[0]) * SC); }
              { const float x1 = bflo(w.y), x2 = bfhi(w.y); w.y = cvtpk((x1 * t0[2] - x2 * t0[3]) * SC, (x1 * t0[3] + x2 * t0[2]) * SC); }
              { const float x1 = bflo(w.z), x2 = bfhi(w.z); w.z = cvtpk((x1 * t1[0] - x2 * t1[1]) * SC, (x1 * t1[1] + x2 * t1[0]) * SC); }
              { const float x1 = bflo(w.w), x2 = bfhi(w.w); w.w = cvtpk((x1 * t1[2] - x2 * t1[3]) * SC, (x1 * t1[3] + x2 * t1[2]) * SC); }
          } else { w.x = cvtpk(bflo(w.x) * SC, bfhi(w.x) * SC); w.y = cvtpk(bflo(w.y) * SC, bfhi(w.y) * SC); w.z = cvtpk(bflo(w.z) * SC, bfhi(w.z) * SC); w.w = cvtpk(bflo(w.w) * SC, bfhi(w.w) * SC); }
          qf[d0] = __builtin_bit_cast(bf16x8, w); } }
    A_WAITBAR(0);
#define A_TOP(t, d1_, d2_) do { if ((((t)) & 1) == 0) { A_DMAK((t) + 2, ((t) + 2) & 3); A_DMAK((t) + 3, ((t) + 3) & 3); A_DMAV((t) + 1, ((t) + 1) & 3); A_DMAV((t) + 2, ((t) + 2) & 3); } } while (0)
#define A_BOT() do { if (t & 1) { A_WAITBAR(0); } } while (0)
    int t = 0, sk = 0, sk2 = 3;
    const int sk1 = 0; (void)sk1;
#define A_ROT() do { sk = (t + 1) & 3; sk2 = t & 3; } while (0)
    {
        if (NTw > 0) {
            f32x16 s0, s1;
            A_QKPRE(sk, s0, s1)
            A_TOP(0, sk2, sk1);
            A_QK(sk, s0, s1, false);
            if (NTw == 1) A_MASK(0, s0, s1);
            float mt; A_ROWMAX(s0, s1, mt);
            mref = mt;
#pragma unroll
            for (int r = 0; r < 16; ++r) { if (TYPE == 0) negm[r] = -mref; p0[r] = __builtin_amdgcn_exp2f(s0[r] - mt); p1[r] = __builtin_amdgcn_exp2f(s1[r] - mt); }
        } else { A_TOP(0, sk2, sk1); }
        A_BOT(); A_ROT();
    }
    for (t = 1; t < NTw; ++t) {
        f32x16 s0, s1;
        A_QKPRE(sk, s0, s1)
        A_TOP(t, sk2, sk1);
        A_QK(sk, s0, s1, true);
        if (t == NTw - 1) A_MASK(t, s0, s1);
        float mt; A_ROWMAX(s0, s1, mt);
        bool resc = false;
        if (__any(mt > THR)) {
            const float dl = fmaxf(mt, 0.f); mref += dl;
#pragma unroll
            for (int r = 0; r < 16; ++r) { s0[r] -= dl; s1[r] -= dl; if (TYPE == 0) negm[r] = -mref; }
            if (hi == 0) wsf[r32] = __builtin_amdgcn_exp2f(-dl);
            resc = true;
        }
        A_PV(sk2, true, s0, s1);
        if (resc) {
            asm volatile("s_waitcnt lgkmcnt(0)" ::: "memory");
#pragma unroll
            for (int g = 0; g < 4; ++g) { const f32x4 al = *(const LAS f32x4*)(wsf + 8 * g + 4 * hi);
#pragma unroll
                for (int i = 0; i < 4; ++i) { o0[4 * g + i] *= al[i]; o1[4 * g + i] *= al[i]; o2[4 * g + i] *= al[i]; } }
            asm volatile("s_waitcnt lgkmcnt(0)" ::: "memory");
        }
        A_BOT(); A_ROT();
    }
    if (NTw > 0) {
        A_TOP(t, sk2, sk1);
        A_PACK();
        A_PV(sk2, false, p0, p1);
        A_BOT(); A_ROT();
        ++t;
    }
    for (; t <= NT; ++t) { A_TOP(t, sk2, sk1); A_BOT(); A_ROT(); }
    asm volatile("s_waitcnt vmcnt(0)" ::: "memory");
    if (active) {
#pragma unroll
        for (int r = 0; r < 16; ++r) { const int q = wid * 32 + crow(r, hi);
            if (q < U.nq) { const float il = __builtin_amdgcn_rcpf(o2[r]); GAS bf16* op = (GAS bf16*)(U.O + (size_t)q * DM + r32); op[0] = (bf16)f2bf(o0[r] * il); op[32] = (bf16)f2bf(o1[r] * il); } }
    }
    __syncthreads();
#undef A_KS
#undef A_VS
#undef A_BS
#undef A_DMA16
#undef A_DMA4
#undef A_DMAK
#undef A_DMAV
#undef A_SB
#undef A_PINW
#undef A_PINP
#undef A_PK1
#undef A_LDK
#undef A_QKPRE
#undef A_QK
#undef A_PACK
#undef A_MASK
#undef A_ROWMAX
#undef A_TR
#undef A_VRD
#undef A_EX0
#undef A_EX1
#undef A_PV
#undef A_WAITBAR
#undef A_TOP
#undef A_BOT
#undef A_ROT
}
__device__ __forceinline__ void attn_phase(const Ctx& a, LAS unsigned char* lds) {
    unsigned char* ws = a.ws();
    const bf16* PROJ = (const bf16*)(ws + WS_PROJ); const bf16* QM = (const bf16*)(ws + WS_QM); const bf16* KV = (const bf16*)(ws + WS_KV); const bf16* KROPE = (const bf16*)(ws + WS_KROPE);
    const bf16* FKS = (const bf16*)(ws + WS_FKS); const bf16* FVS = (const bf16*)(ws + WS_FVS); const float* LKB = (const float*)(ws + WS_LK); bf16* OB = (bf16*)(ws + WS_XN);
    unsigned* qctr = (unsigned*)(ws + WS_QCTR);
    const int myx = (int)(__builtin_amdgcn_s_getreg((3 << 11) | 20) & 7u);
    LAS int* slot = (LAS int*)(lds + PTR_OFF + 256);
    int qoff = 0;
    for (;;) {
        if (threadIdx.x == 0) {
            int e = -1, x = 0;
            while (qoff < 8) { x = (myx + qoff) & 7; const unsigned v = atomicAdd(qctr + 64 * x, 1u); if (v < 272u) { e = (int)v; break; } ++qoff; }
            slot[0] = e; slot[1] = x;
        }
        __syncthreads();
        const int e = slot[0], x = slot[1];
        __syncthreads();
        if (e < 0) break;
        const int nhalf = e < 256 ? 2 : 1;
        for (int half = 0; half < nhalf; ++half) {
            AttnUnit U; int type; U.TAB = (const float*)(ws + WS_TAB);
            if (e < 256) {
                const int ks = e >> 4, jj = e & 15;
                const int s = x + 8 * ks; type = s >> 6; const int b = (s >> 3) & 7, h = s & 7, qb = half ? 31 - jj : jj; const size_t r0 = (size_t)b * SEQ, q0 = r0 + 256 * qb;
                U.nkeys = SEQ; U.qpos0 = 256 * qb; U.nq = 256;
                if (type == 0) { U.Q = QM + q0 * NQ + 96 * h; U.qpitch = NQ; U.K = KV + r0 * NKV + 128 * h; U.kpitch = NKV; U.KR = KROPE + r0 * 32; U.V = KV + r0 * NKV + 128 * h + 64; U.vpitch = NKV; U.LK = nullptr; U.O = OB + q0 * DM + 64 * h; }
                else { U.Q = PROJ + q0 * NINP + C_FQ + 64 * h; U.qpitch = NINP; U.K = PROJ + r0 * NINP + C_FK + 64 * h; U.kpitch = NINP; U.KR = nullptr; U.V = PROJ + r0 * NINP + C_FV + 64 * h; U.vpitch = NINP; U.LK = LKB + r0 * 8 + h; U.O = OB + q0 * DM + 512 + 64 * h; }
            } else {
                const int j = e - 256; type = j >> 3; const int b = j & 7, h = x; const size_t q0 = (size_t)NP + 16 * b, r0 = (size_t)NP + (size_t)b * SKEYS;
                U.nkeys = SKEYS; U.qpos0 = PAST; U.nq = DSEQ;
                if (type == 0) { U.Q = QM + q0 * NQ + 96 * h; U.qpitch = NQ; U.K = KV + r0 * NKV + 128 * h; U.kpitch = NKV; U.KR = KROPE + r0 * 32; U.V = KV + r0 * NKV + 128 * h + 64; U.vpitch = NKV; U.LK = nullptr; U.O = OB + q0 * DM + 64 * h; }
                else { U.Q = PROJ + q0 * NINP + C_FQ + 64 * h; U.qpitch = NINP; U.K = FKS + (size_t)b * SKEYS * 512 + 64 * h; U.kpitch = 512; U.KR = nullptr; U.V = FVS + (size_t)b * SKEYS * 512 + 64 * h; U.vpitch = 512; U.LK = LKB + r0 * 8 + h; U.O = OB + q0 * DM + 512 + 64 * h; }
            }
            if (type == 0) attn_unit<0>(lds, U); else attn_unit<1>(lds, U);
        }
    }
}

template <class Epi> __device__ __forceinline__ void run_gemm(LAS unsigned char* lds, const bf16* A, const bf16* Bt, int M, int N, int K, const Epi& E) {
    pg8::Gemm g{A, Bt, M, N, K}; pg8::StaticOrder S; S.init(M, N, (int)gridDim.x, (int)blockIdx.x);
    pg8::gemm_phase<Epi, pg8::StaticOrder, true, true>(lds, g, S, E);
}
#define XB_TMO      128
#define XB_XCNT(j)  (256  + 64 * (j))
#define XB_XSUB(j)  (1280 + 64 * (j))
#define XB_XGEN(j)  (2304 + 64 * (j))
#define XB_TOP      3328
#define XB_TOPGEN   3392
#define XCD_BAR_WORDS 3456
#define XB_SPIN_CAP (1u << 18)

__device__ __forceinline__ unsigned xb_ld(unsigned* p)              { return __hip_atomic_load(p, __ATOMIC_RELAXED, __HIP_MEMORY_SCOPE_AGENT); }
__device__ __forceinline__ unsigned xb_add(unsigned* p, unsigned v) { return __hip_atomic_fetch_add(p, v, __ATOMIC_RELAXED, __HIP_MEMORY_SCOPE_AGENT); }
__device__ __forceinline__ unsigned xb_xcc_id() { return (unsigned)__builtin_amdgcn_s_getreg((3 << 11) | 20) & 0xFu; }
#define XB_SPIN(cond, bar) do { unsigned _sp = 0; while (cond) { __builtin_amdgcn_s_sleep(1); \
    if ((++_sp & 255u) == 0u) { if (xb_ld(&(bar)[XB_TMO])) break; if (_sp > XB_SPIN_CAP) { atomicAdd(&(bar)[XB_TMO], 1u); break; } } } } while (0)

struct XcdBarrier {
    unsigned* bar; unsigned x;
    volatile LAS unsigned* st;
};

__device__ __forceinline__ XcdBarrier xcd_barrier_post(unsigned* bar, volatile LAS unsigned* st) {
    XcdBarrier b; b.bar = bar; b.x = xb_xcc_id(); b.st = st;
    if (threadIdx.x == 0) (void)xb_add(&bar[XB_XCNT(b.x)], 1u);
    return b;
}
__device__ __forceinline__ void xcd_barrier_complete(unsigned* bar, unsigned x, unsigned& nloc, unsigned& nx) {
    const unsigned G = gridDim.x * gridDim.y * gridDim.z;
    unsigned sum, cnt, mine, sp = 0u;
    for (;;) {
        sum = 0u; cnt = 0u; mine = 0u;
#pragma unroll
        for (unsigned j = 0; j < 16; ++j) { const unsigned c = xb_ld(&bar[XB_XCNT(j)]); sum += c; cnt += (c > 0u) ? 1u : 0u; mine = (j == x) ? c : mine; }
        if (sum == G) break;
        __builtin_amdgcn_s_sleep(1);
        if ((++sp & 255u) == 0u) { if (xb_ld(&bar[XB_TMO])) break; if (sp > XB_SPIN_CAP) { atomicAdd(&bar[XB_TMO], 1u); break; } }
    }
    nloc = mine > 0u ? mine : 1u; nx = cnt > 0u ? cnt : 1u;
}

__device__ __forceinline__ void xcd_barrier(const XcdBarrier& b) {
    asm volatile("s_waitcnt vmcnt(0)" ::: "memory");
    __syncthreads();
    if (threadIdx.x == 0) {
        unsigned* bar = b.bar;
        __builtin_amdgcn_s_waitcnt(0);
        unsigned nloc = b.st[0], nx = b.st[1];
        if (nloc == 0u) { xcd_barrier_complete(bar, b.x, nloc, nx); b.st[0] = nloc; b.st[1] = nx; }
        const unsigned old = xb_add(&bar[XB_XSUB(b.x)], 1u);
        const unsigned gen = old / nloc;
        if (old + 1u == (gen + 1u) * nloc) {
            __builtin_amdgcn_fence(__ATOMIC_RELEASE, "agent");
            asm volatile("s_waitcnt vmcnt(0)" ::: "memory");
            const unsigned og = xb_add(&bar[XB_TOP], 1u);
            const unsigned tg = og / nx;
            if (og + 1u == (tg + 1u) * nx) xb_add(&bar[XB_TOPGEN], 1u);
            else XB_SPIN(xb_ld(&bar[XB_TOPGEN]) == tg, bar);
            __builtin_amdgcn_fence(__ATOMIC_ACQUIRE, "agent");
            xb_add(&bar[XB_XGEN(b.x)], 1u);
            asm volatile("s_waitcnt vmcnt(0)" ::: "memory");
        } else {
            XB_SPIN(xb_ld(&bar[XB_XGEN(b.x)]) == gen, bar);
            __builtin_amdgcn_fence(__ATOMIC_ACQUIRE, "agent");
            asm volatile("s_waitcnt vmcnt(0)" ::: "memory");
        }
    }
    __syncthreads();
}

__device__ __forceinline__ void blk_signal(unsigned* flag) { __threadfence(); __syncthreads(); if (threadIdx.x == 0) __hip_atomic_fetch_add(flag, 1u, __ATOMIC_RELEASE, __HIP_MEMORY_SCOPE_AGENT); }
__device__ __forceinline__ void blk_wait(unsigned* flag, unsigned n) {
    if (threadIdx.x == 0) { while (__hip_atomic_load(flag, __ATOMIC_ACQUIRE, __HIP_MEMORY_SCOPE_AGENT) < n) __builtin_amdgcn_s_sleep(8); }
    __syncthreads(); __threadfence();
}
__global__ void __launch_bounds__(512, 2) mega_fwd(Args a) {
    extern __shared__ __attribute__((aligned(16))) unsigned char lds_raw[];
    LAS unsigned char* lds = (LAS unsigned char*)lds_raw;
    cg::grid_group grid = cg::this_grid();
#define PH_IDS() int tid_l_ = threadIdx.x; asm volatile("" : "+v"(tid_l_)); const int tid = tid_l_, lane = tid & 63, wave = __builtin_amdgcn_readfirstlane(tid >> 6), gw = blockIdx.x * 8 + wave, NGW = gridDim.x * 8; (void)tid; (void)lane; (void)wave; (void)gw; (void)NGW
    { const unsigned long long* ka = (const unsigned long long*)__builtin_amdgcn_kernarg_segment_ptr(); const int tid = threadIdx.x;
      if (tid < 26) *(LAS unsigned long long*)(lds + PTR_OFF + 8 * tid) = ka[tid];
      if (tid < 2) *(LAS unsigned*)(lds + PTR_OFF + 512 + 4 * tid) = 0u; }
    __syncthreads();
    const Ctx c{lds};
#define WSP(T, off) ((T*)(c.ws() + (off)))
    { PH_IDS(); LAS float* scr = (LAS float*)(lds + wave * 16384);
      transpose_w4(c.in(I_W1GU), DM, NGU, WSP(bf16, WS_WGU1), NGU, MapGU(), scr, gw, NGW, lane);
      transpose_w4(c.in(I_W1D), DFF, DM, WSP(bf16, WS_WD1), DM, MapId(), scr, gw, NGW, lane);
      transpose_w4(c.in(I_W2GU), DM, NGU, WSP(bf16, WS_WGU2), NGU, MapGU(), scr, gw, NGW, lane);
      transpose_w4(c.in(I_W2D), DFF, DM, WSP(bf16, WS_WD2), DM, MapId(), scr, gw, NGW, lane);
      transpose_w(c.in(I_WIN), DM, NIN, WSP(bf16, WS_WIN), NINP, MapIn(), scr, gw, NGW, lane);
      transpose_w(c.in(I_WQ), QLORA, NQ, WSP(bf16, WS_WQ), NQ, MapQ(), scr, gw, NGW, lane);
      transpose_w4(c.in(I_WKV), KVLORA, NKV, WSP(bf16, WS_WKV), NKV, MapId(), scr, gw, NGW, lane);
      transpose_w4(c.in(I_WO), DM, DM, WSP(bf16, WS_WO), DM, MapId(), scr, gw, NGW, lane);
      { float* TAB = WSP(float, WS_TAB); for (int e = gw * 64 + lane; e < SEQ * 16; e += NGW * 64) { float cc, ss; rope_cs(e >> 4, e & 15, cc, ss); TAB[2 * e] = cc; TAB[2 * e + 1] = ss; } }
      if (blockIdx.x == 0 && tid < 16) WSP(unsigned, WS_QCTR)[64 * tid] = 0u;
      if (blockIdx.x == 1) { for (int w = tid; w < XCD_BAR_WORDS; w += 512) WSP(unsigned, WS_BAR)[w] = 0u; }
      rp_norm_only(c, c.in(I_G1PRE), WSP(bf16, WS_XN), gw, NGW, lane); }
    grid.sync();
    const XcdBarrier xbar = xcd_barrier_post(WSP(unsigned, WS_BAR), (volatile LAS unsigned*)(lds + PTR_OFF + 512));
#define GSYNC() xcd_barrier(xbar)
#define FLAG(i) (WSP(unsigned, WS_QCTR) + 512 + 64 * (i))
#define SROW(T, off, ld) (WSP(T, off) + (size_t)NP * (ld))
    run_gemm(lds, WSP(bf16, WS_XN), WSP(bf16, WS_WGU1), MPAD, NGU, DM, pg8::EpiSwiGLU{WSP(bf16, WS_ACT), DFF});
    GSYNC();
    run_gemm(lds, WSP(bf16, WS_ACT), WSP(bf16, WS_WD1), NP, DM, DFF, pg8::EpiStore{WSP(bf16, WS_D), DM});
    GSYNC();
    if (blockIdx.x < 4) {
        run_gemm(lds, SROW(bf16, WS_ACT, DFF), WSP(bf16, WS_WD1), 256, DM, DFF, pg8::EpiStore{SROW(bf16, WS_D, DM), DM}); blk_signal(FLAG(1));
        { blk_wait(FLAG(1), 4); PH_IDS(); rp_residual(c, true, false, WSP(bf16, WS_D), 0.5f, c.in(I_G1POST), c.in(I_GMPRE), c.out(), WSP(bf16, WS_XN), NP, NTOK, gw, 4 * 8, lane); }
    } else { PH_IDS(); rp_residual(c, true, false, WSP(bf16, WS_D), 0.5f, c.in(I_G1POST), c.in(I_GMPRE), c.out(), WSP(bf16, WS_XN), 0, NP, gw - 4 * 8, NGW - 4 * 8, lane);
    }
    GSYNC();
    run_gemm(lds, WSP(bf16, WS_XN), WSP(bf16, WS_WIN), NP, NINP, DM, pg8::EpiStore{WSP(bf16, WS_PROJ), NINP});
    GSYNC();
    if (blockIdx.x < 9) {
        run_gemm(lds, SROW(bf16, WS_XN, DM), WSP(bf16, WS_WIN), 256, NINP, DM, pg8::EpiStore{SROW(bf16, WS_PROJ, NINP), NINP});
        blk_signal(FLAG(2));
        { blk_wait(FLAG(2), 9); PH_IDS(); rp_mix(c, NP, NTOK, false, gw, 9 * 8, lane); }
    } else { PH_IDS(); rp_mix(c, 0, NP, true, gw - 9 * 8, NGW - 9 * 8, lane); }
    GSYNC();
    run_gemm(lds, WSP(bf16, WS_CQN), WSP(bf16, WS_WQ), MPAD, NQ, QLORA, pg8::EpiStore{WSP(bf16, WS_QM), NQ});
    run_gemm(lds, WSP(bf16, WS_CKVN), WSP(bf16, WS_WKV), KPAD, NKV, KVLORA, pg8::EpiStore{WSP(bf16, WS_KV), NKV});
    for (int i = blockIdx.x; i < 128; i += gridDim.x) {
        PH_IDS(); const int b = (i >> 3) & 7, h = i & 7;
        if (i < 64) scan_item(c.out() + O_LFP + (size_t)b * SEQ * 8 + h, WSP(float, WS_LK) + (size_t)b * SEQ * 8 + h, SEQ, (LAS float*)lds, tid);
        else scan_item(WSP(float, WS_LFS) + (size_t)b * SKEYS * 8 + h, WSP(float, WS_LK) + ((size_t)NP + (size_t)b * SKEYS) * 8 + h, SKEYS, (LAS float*)lds, tid);
        __syncthreads();
    }
    GSYNC();
    attn_phase(c, lds);
    GSYNC();
    run_gemm(lds, WSP(bf16, WS_XN), WSP(bf16, WS_WO), NP, DM, DM, pg8::EpiStore{WSP(bf16, WS_D), DM});
    GSYNC();
    if (blockIdx.x < 4) {
        run_gemm(lds, SROW(bf16, WS_XN, DM), WSP(bf16, WS_WO), 256, DM, DM, pg8::EpiStore{SROW(bf16, WS_D, DM), DM});
        blk_signal(FLAG(3));
        { blk_wait(FLAG(3), 4); PH_IDS(); rp_residual(c, false, false, WSP(bf16, WS_D), 1.0f, c.in(I_GMPOST), c.in(I_G2PRE), c.out(), WSP(bf16, WS_XN), NP, NTOK, gw, 4 * 8, lane); }
    } else { PH_IDS(); rp_residual(c, false, false, WSP(bf16, WS_D), 1.0f, c.in(I_GMPOST), c.in(I_G2PRE), c.out(), WSP(bf16, WS_XN), 0, NP, gw - 4 * 8, NGW - 4 * 8, lane);
    }
    GSYNC();
    run_gemm(lds, WSP(bf16, WS_XN), WSP(bf16, WS_WGU2), MPAD, NGU, DM, pg8::EpiSwiGLU{WSP(bf16, WS_ACT), DFF});
    GSYNC();
    run_gemm(lds, WSP(bf16, WS_ACT), WSP(bf16, WS_WD2), NP, DM, DFF, pg8::EpiStore{WSP(bf16, WS_D), DM});
    GSYNC();
    if (blockIdx.x < 4) {
        run_gemm(lds, SROW(bf16, WS_ACT, DFF), WSP(bf16, WS_WD2), 256, DM, DFF, pg8::EpiStore{SROW(bf16, WS_D, DM), DM}); blk_signal(FLAG(5));
        { blk_wait(FLAG(5), 4); PH_IDS(); rp_residual(c, false, true, WSP(bf16, WS_D), 0.5f, c.in(I_G2POST), nullptr, c.out(), WSP(bf16, WS_XN), NP, NTOK, gw, 4 * 8, lane); }
    } else { PH_IDS(); rp_residual(c, false, true, WSP(bf16, WS_D), 0.5f, c.in(I_G2POST), nullptr, c.out(), WSP(bf16, WS_XN), 0, NP, gw - 4 * 8, NGW - 4 * 8, lane);
    }
#undef FLAG
#undef SROW
#undef WSP
#undef PH_IDS
#undef GSYNC
}

extern "C" void kernel_launch(void* const* d_in, const int* in_sizes, int n_in, void* d_out, int out_size, void* d_ws, size_t ws_size, hipStream_t stream) {
    static int grid_blocks = 0;
    if (grid_blocks == 0) {
        if (n_in != 24 || (size_t)out_size != O_END || ws_size < WS_END) { fprintf(stderr, "kernel_launch: unexpected shapes: n_in %d out %d ws %zu (need %zu)\n", n_in, out_size, ws_size, (size_t)WS_END); grid_blocks = -1; return; }
        int dev = 0, cus = 0, per_cu = 0;
        hipGetDevice(&dev); hipDeviceGetAttribute(&cus, hipDeviceAttributeMultiprocessorCount, dev);
        if (hipFuncSetAttribute((const void*)mega_fwd, hipFuncAttributeMaxDynamicSharedMemorySize, LDS_BYTES) != hipSuccess) { fprintf(stderr, "kernel_launch: hipFuncSetAttribute failed\n"); grid_blocks = -1; return; }
        if (hipOccupancyMaxActiveBlocksPerMultiprocessor(&per_cu, (const void*)mega_fwd, 512, LDS_BYTES) != hipSuccess || per_cu < 1) { fprintf(stderr, "kernel_launch: occupancy query says %d\n", per_cu); per_cu = 1; (void)hipGetLastError(); }
        grid_blocks = cus * per_cu;
    }
    if (grid_blocks < 0) return;
    Args a{};
    for (int i = 0; i < 24; ++i) a.in[i] = (const float*)d_in[i];
    a.out = (float*)d_out; a.ws = (unsigned char*)d_ws;
    void* args[] = {&a};
    hipError_t e = hipLaunchCooperativeKernel((const void*)mega_fwd, dim3(grid_blocks), dim3(512), args, LDS_BYTES, stream);
    if (e != hipSuccess) fprintf(stderr, "cooperative launch failed: %s (grid %d)\n", hipGetErrorString(e), grid_blocks);
}
```

```cpp
#include <hip/hip_runtime.h>
#include <hip/hip_cooperative_groups.h>
#include <cstdio>
#include <cstdint>
namespace cg = cooperative_groups;
namespace pg8 {
#define PG8_LAS __attribute__((address_space(3)))
typedef unsigned short bf16_t;
typedef short bf16x8 __attribute__((ext_vector_type(8)));
typedef float f32x4 __attribute__((ext_vector_type(4)));
typedef unsigned u32x4 __attribute__((ext_vector_type(4)));
constexpr int BM = 256, BK = 64, HALF = 128, HTB = HALF * BK * 2  , STAGE_BYTES = 8 * HTB, NXCD = 8, WGM = 8;

__host__ __device__ __forceinline__ int lds_byte(int r, int c) { const int st = (r >> 4) * 2 + (c >> 5), rr = r & 15, cc = c & 31, ob = rr * 64 + cc * 2; return st * 1024 + (ob ^ (((ob >> 9) & 1) << 5)); }
__host__ __device__ __forceinline__ void stage_rc(int b, int& R, int& C) { const int st = b / 1024, sb = b % 1024, swz = sb ^ (((sb >> 9) & 1) << 5); R = (st >> 1) * 16 + swz / 64; C = (st & 1) * 32 + (swz % 64) / 2; }
__host__ __device__ __forceinline__ int perm32(int rho) { const int n = rho >> 4, i = rho & 15; return 8 * (i >> 2) + 4 * n + (i & 3); }

struct Unit { int pm, pn; };
struct Gemm { const bf16_t* A; const bf16_t* Bt; int M, N, K; };

struct StaticOrder {
    int nM, nN, nwg, G, c;
    __host__ __device__ void init(int M, int N, int G_, int c_) { nM = M / BM; nN = N / BM; nwg = nM * nN; G = G_; c = c_; }
    __host__ __device__ bool next(int i, Unit& u) const {
        const long L = (long)i * G + c; if (L >= nwg) return false;
        int wgid = (int)L; { const int q = nwg / NXCD, r = nwg % NXCD, xcd = wgid % NXCD, off = wgid / NXCD; wgid = (xcd < r ? xcd * (q + 1) : r * (q + 1) + (xcd - r) * q) + off; }
        const int nig = WGM * nN, gid = wgid / nig, fm = gid * WGM, gsz = (nM - fm) < WGM ? (nM - fm) : WGM;
        u.pm = fm + ((wgid % nig) % gsz); u.pn = (wgid % nig) / gsz; return true;
    }
    __device__ __forceinline__ void a_ready(const Unit&) const {}
    __device__ __forceinline__ void done(const Unit&) const {}
};

__device__ __forceinline__ unsigned cvt_pk_bf16(float lo, float hi) { unsigned r; asm volatile("v_cvt_pk_bf16_f32 %0, %1, %2" : "=v"(r) : "v"(lo), "v"(hi)); return r; }
typedef float f32x2 __attribute__((ext_vector_type(2)));
struct EpiStore {
    static constexpr bool PERM = true, AFTER_DRAIN = false;
    bf16_t* O; int ldc;
    __device__ __forceinline__ void operator()(const f32x4 (&acc)[2][2][4][2], const Unit& u, int wr, int wc, int fr, int fq) const {
        const int row0 = u.pm * BM + wr * 64 + fr, col0 = u.pn * BM + wc * 32 + 8 * fq;
#pragma unroll
        for (int ai = 0; ai < 2; ++ai)
#pragma unroll
            for (int m = 0; m < 4; ++m) { bf16_t* rowp = O + (size_t)(row0 + ai * HALF + m * 16) * ldc + col0;
#pragma unroll
                for (int bj = 0; bj < 2; ++bj) { const f32x4 v0 = acc[ai][bj][m][0], v1 = acc[ai][bj][m][1];
                    u32x4 w; w.x = cvt_pk_bf16(v0[0], v0[1]); w.y = cvt_pk_bf16(v0[2], v0[3]); w.z = cvt_pk_bf16(v1[0], v1[1]); w.w = cvt_pk_bf16(v1[2], v1[3]);
                    *(u32x4*)(rowp + bj * HALF) = w; } }
    }
};
__device__ __forceinline__ float silu_mul(float g, float u) { return g * u * __builtin_amdgcn_rcpf(1.0f + __builtin_amdgcn_exp2f(-1.4426950408889634f * g)); }
struct EpiSwiGLU {
    static constexpr bool PERM = true, AFTER_DRAIN = false;
    bf16_t* O; int ldc;
    __device__ __forceinline__ void operator()(const f32x4 (&acc)[2][2][4][2], const Unit& u, int wr, int wc, int fr, int fq) const {
        const int row0 = u.pm * BM + wr * 64 + fr, col0 = u.pn * HALF + wc * 32 + 8 * fq;
#pragma unroll
        for (int ai = 0; ai < 2; ++ai)
#pragma unroll
            for (int m = 0; m < 4; ++m) { bf16_t* rowp = O + (size_t)(row0 + ai * HALF + m * 16) * ldc + col0;
                const f32x4 g0 = acc[ai][0][m][0], g1 = acc[ai][0][m][1], u0 = acc[ai][1][m][0], u1 = acc[ai][1][m][1];
                u32x4 w; w.x = cvt_pk_bf16(silu_mul(g0[0], u0[0]), silu_mul(g0[1], u0[1])); w.y = cvt_pk_bf16(silu_mul(g0[2], u0[2]), silu_mul(g0[3], u0[3]));
                w.z = cvt_pk_bf16(silu_mul(g1[0], u1[0]), silu_mul(g1[1], u1[1])); w.w = cvt_pk_bf16(silu_mul(g1[2], u1[2]), silu_mul(g1[3], u1[3]));
                *(u32x4*)rowp = w; }
    }
};
template <class Epi, class Sched, bool ALIGN_EPI = false, bool SP2 = false>
__device__ __forceinline__ void gemm_phase(PG8_LAS unsigned char* lds, const Gemm g, const Sched& S, const Epi& E) {
    int tid_ = threadIdx.x; asm volatile("" : "+v"(tid_));
    const int tid = tid_, wid = __builtin_amdgcn_readfirstlane(tid >> 6), lane = tid & 63, wr = wid >> 2, wc = wid & 3, fr = lane & 15, fq = lane >> 4;
    const int K = g.K, nt = K / BK;
    unsigned voffA[2], voffB[2];
#pragma unroll
    for (int i = 0; i < 2; ++i) { int R, C; stage_rc(tid * 16 + i * 8192, R, C); const int Rb = Epi::PERM ? ((R & ~31) + perm32(R & 31)) : R;
        voffA[i] = (unsigned)(R * K + C) * 2u; voffB[i] = (unsigned)(Rb * K + C) * 2u; }
    const size_t kstep = (size_t)(BK * 2);
    const size_t hstep = (size_t)HALF * K * 2;
    const size_t tstep = 2 * hstep;
    const unsigned ldsw = (unsigned)wid * 1024u;
    const int aoff = lds_byte(wr * 64 + fr, fq * 8), boff = lds_byte(wc * 32 + fr, fq * 8);
#define PG8_SA(b, h) (((b) * 2 + (h)) * HTB)
#define PG8_SB(b, h) ((4 + (b) * 2 + (h)) * HTB)
#define PG8_STAGE(bufoff, gbase, voff) do { _Pragma("unroll") for (int _i = 0; _i < 2; ++_i) \
        __builtin_amdgcn_global_load_lds((const unsigned*)((const char*)(gbase) + (voff)[_i]), (PG8_LAS unsigned*)(lds + (bufoff) + ldsw + _i * 8192), 16, 0, 0); } while (0)
#define PG8_LDA(dst, b, h) do { _Pragma("unroll") for (int m = 0; m < 4; ++m) _Pragma("unroll") for (int k = 0; k < 2; ++k) dst[m][k] = *(const PG8_LAS bf16x8*)(lds + PG8_SA(b, h) + aoff + m * 2048 + k * 1024); } while (0)
#define PG8_LDB(dst, b, h) do { _Pragma("unroll") for (int n = 0; n < 2; ++n) _Pragma("unroll") for (int k = 0; k < 2; ++k) dst[n][k] = *(const PG8_LAS bf16x8*)(lds + PG8_SB(b, h) + boff + n * 2048 + k * 1024); } while (0)
#define PG8_MMA(ai, bj, At, Bt) do { __builtin_amdgcn_s_setprio(1); _Pragma("unroll") for (int m = 0; m < 4; ++m) _Pragma("unroll") for (int n = 0; n < 2; ++n) _Pragma("unroll") for (int k = 0; k < 2; ++k) \
        acc[ai][bj][m][n] = __builtin_amdgcn_mfma_f32_16x16x32_bf16(Bt[n][k], At[m][k], acc[ai][bj][m][n], 0, 0, 0); __builtin_amdgcn_s_setprio(0); } while (0)
#define PG8_WAIT_V(n) asm volatile("s_waitcnt vmcnt(" #n ")" ::: "memory")
#define PG8_WAIT_L(n) asm volatile("s_waitcnt lgkmcnt(" #n ")" ::: "memory")
#define PG8_BAR __builtin_amdgcn_s_barrier()
#define PG8_SCHED __builtin_amdgcn_sched_barrier(0)
    Unit cur, nxt; int ui = 0;
    if (!S.next(0, cur)) return;
    f32x4 acc[2][2][4][2];
#pragma unroll
    for (int a = 0; a < 2; ++a)
#pragma unroll
        for (int b = 0; b < 2; ++b)
#pragma unroll
            for (int m = 0; m < 4; ++m)
#pragma unroll
                for (int n = 0; n < 2; ++n) acc[a][b][m][n] = (f32x4){0.f, 0.f, 0.f, 0.f};
    bf16x8 At[4][2], B0[2][2], B1[2][2];
    const char* cA = (const char*)g.A + (size_t)cur.pm * tstep; const char* cB = (const char*)g.Bt + (size_t)cur.pn * tstep;
    S.a_ready(cur);
    if constexpr (SP2) {
        PG8_STAGE(PG8_SB(0, 0), cB, voffB); PG8_STAGE(PG8_SB(0, 1), cB + hstep, voffB); PG8_STAGE(PG8_SA(0, 0), cA, voffA); PG8_STAGE(PG8_SA(0, 1), cA + hstep, voffA);
        if (wr == 1) PG8_BAR;
        PG8_WAIT_V(2); PG8_BAR;
        PG8_STAGE(PG8_SB(1, 0), cB + kstep, voffB); PG8_STAGE(PG8_SA(1, 0), cA + kstep, voffA); PG8_STAGE(PG8_SB(1, 1), cB + hstep + kstep, voffB);
        PG8_WAIT_V(6); PG8_BAR;
    } else {
        PG8_STAGE(PG8_SB(0, 0), cB, voffB); PG8_STAGE(PG8_SA(0, 0), cA, voffA); PG8_STAGE(PG8_SB(0, 1), cB + hstep, voffB); PG8_STAGE(PG8_SA(0, 1), cA + hstep, voffA);
        if (wr == 1) PG8_BAR;
        PG8_WAIT_V(4); PG8_BAR;
        PG8_STAGE(PG8_SB(1, 0), cB + kstep, voffB); PG8_STAGE(PG8_SA(1, 0), cA + kstep, voffA); PG8_STAGE(PG8_SB(1, 1), cB + hstep + kstep, voffB);
        PG8_WAIT_V(6); PG8_BAR;
    }
    for (;;) {
        const bool has_next = S.next(ui + 1, nxt);
        const char* nA = has_next ? (const char*)g.A + (size_t)nxt.pm * tstep : cA; const char* nB = has_next ? (const char*)g.Bt + (size_t)nxt.pn * tstep : cB;
        for (int t = 0; t < nt; t += 2) {
            const bool last = (t == nt - 2);
            const char* a1 = cA + (size_t)(t + 1) * kstep;
            const char* a2 = last ? nA : cA + (size_t)(t + 2) * kstep; const char* b2 = last ? nB : cB + (size_t)(t + 2) * kstep;
            const char* a3 = a2 + kstep; const char* b3 = b2 + kstep;
            if (last && has_next) S.a_ready(nxt);
            if constexpr (SP2) {
            PG8_LDB(B0, 0, 0); PG8_LDB(B1, 0, 1); PG8_SCHED; PG8_LDA(At, 0, 0); PG8_STAGE(PG8_SA(1, 1), a1 + hstep, voffA);
            PG8_WAIT_V(8); PG8_WAIT_L(0); PG8_BAR; PG8_MMA(0, 0, At, B0); PG8_MMA(0, 1, At, B1); PG8_BAR; PG8_SCHED;
            PG8_LDA(At, 0, 1); PG8_STAGE(PG8_SB(0, 0), b2, voffB); PG8_STAGE(PG8_SB(0, 1), b2 + hstep, voffB); PG8_STAGE(PG8_SA(0, 0), a2, voffA);
            PG8_WAIT_V(8); PG8_WAIT_L(0); PG8_BAR; PG8_MMA(1, 0, At, B0); PG8_MMA(1, 1, At, B1); PG8_BAR; PG8_SCHED;
            PG8_LDB(B0, 1, 0); PG8_LDB(B1, 1, 1); PG8_SCHED; PG8_LDA(At, 1, 0); PG8_STAGE(PG8_SA(0, 1), a2 + hstep, voffA);
            PG8_WAIT_V(8); PG8_WAIT_L(0); PG8_BAR; PG8_MMA(0, 0, At, B0); PG8_MMA(0, 1, At, B1); PG8_BAR; PG8_SCHED;
            PG8_LDA(At, 1, 1); PG8_STAGE(PG8_SB(1, 0), b3, voffB); PG8_STAGE(PG8_SB(1, 1), b3 + hstep, voffB); PG8_STAGE(PG8_SA(1, 0), a3, voffA);
            PG8_WAIT_V(8); PG8_WAIT_L(0); PG8_BAR; PG8_MMA(1, 0, At, B0); PG8_MMA(1, 1, At, B1); PG8_BAR; PG8_SCHED;
            } else {
            PG8_LDB(B0, 0, 0); PG8_SCHED; PG8_LDA(At, 0, 0); PG8_STAGE(PG8_SA(1, 1), a1 + hstep, voffA);
            PG8_WAIT_L(8); PG8_BAR; PG8_WAIT_L(0); PG8_MMA(0, 0, At, B0); PG8_BAR; PG8_SCHED;
            PG8_LDB(B1, 0, 1); PG8_STAGE(PG8_SB(0, 0), b2, voffB);
            PG8_BAR; PG8_WAIT_L(0); PG8_MMA(0, 1, At, B1); PG8_BAR;
            PG8_LDA(At, 0, 1); PG8_STAGE(PG8_SA(0, 0), a2, voffA);
            PG8_BAR; PG8_WAIT_L(0); PG8_MMA(1, 0, At, B0); PG8_BAR; PG8_SCHED;
            PG8_STAGE(PG8_SB(0, 1), b2 + hstep, voffB);
            PG8_WAIT_V(6); PG8_BAR; PG8_MMA(1, 1, At, B1); PG8_BAR;
            PG8_LDB(B0, 1, 0); PG8_SCHED; PG8_LDA(At, 1, 0); PG8_STAGE(PG8_SA(0, 1), a2 + hstep, voffA);
            PG8_WAIT_L(8); PG8_BAR; PG8_WAIT_L(0); PG8_MMA(0, 0, At, B0); PG8_BAR; PG8_SCHED;
            PG8_LDB(B1, 1, 1); PG8_STAGE(PG8_SB(1, 0), b3, voffB);
            PG8_BAR; PG8_WAIT_L(0); PG8_MMA(0, 1, At, B1); PG8_BAR;
            PG8_LDA(At, 1, 1); PG8_STAGE(PG8_SA(1, 0), a3, voffA);
            PG8_BAR; PG8_WAIT_L(0); PG8_MMA(1, 0, At, B0); PG8_BAR; PG8_SCHED;
            PG8_STAGE(PG8_SB(1, 1), b3 + hstep, voffB);
            PG8_WAIT_V(6); PG8_BAR; PG8_MMA(1, 1, At, B1); PG8_BAR;
            }
        }
        if constexpr (ALIGN_EPI) { if (wr == 0) PG8_BAR; }
        if constexpr (!Epi::AFTER_DRAIN) { E(acc, cur, wr, wc, fr, fq); S.done(cur); }
        if (!has_next) break;
#pragma unroll
        for (int a = 0; a < 2; ++a)
#pragma unroll
            for (int b = 0; b < 2; ++b)
#pragma unroll
                for (int m = 0; m < 4; ++m)
#pragma unroll
                    for (int n = 0; n < 2; ++n) acc[a][b][m][n] = (f32x4){0.f, 0.f, 0.f, 0.f};
        cur = nxt; cA = nA; cB = nB; ++ui;
        if constexpr (ALIGN_EPI) { if (wr == 1) PG8_BAR; }
    }
    PG8_WAIT_V(0);
    if constexpr (!ALIGN_EPI) { if (wr == 0) PG8_BAR; }
    PG8_BAR;
    if constexpr (Epi::AFTER_DRAIN) { E.fused(acc, cur, wr, wc, fr, fq, lds, wid, lane); S.done(cur); }
#undef PG8_SA
#undef PG8_SB
#undef PG8_STAGE
#undef PG8_LDA
#undef PG8_LDB
#undef PG8_MMA
#undef PG8_WAIT_V
#undef PG8_WAIT_L
#undef PG8_BAR
#undef PG8_SCHED
}
}

#define LAS __attribute__((address_space(3)))
#define GAS __attribute__((address_space(1)))
typedef unsigned short bf16;
typedef float f32x4 __attribute__((ext_vector_type(4)));
typedef float f32x16 __attribute__((ext_vector_type(16)));
typedef short bf16x8 __attribute__((ext_vector_type(8)));
typedef short s16x4 __attribute__((ext_vector_type(4)));
typedef unsigned u32x4 __attribute__((ext_vector_type(4)));
typedef unsigned u32x2 __attribute__((ext_vector_type(2)));

constexpr int DM = 1024, NP = 65536, NS = 128, NTOK = NP + NS, MPAD = 65792;
constexpr int SEQ = 8192, PAST = 4096, DSEQ = 16, SKEYS = PAST + DSEQ;
constexpr int KROWS = NP + 8 * SKEYS, KPAD = 98560;
constexpr int DFF = 2816, NGU = 2 * DFF, NIN = 2216, NINP = 2304, QLORA = 384, KVLORA = 256, NQ = 768, NKV = 1024;
constexpr int C_CKV = 384, C_KR = 640, C_FQ = 672, C_FK = 1184, C_FV = 1696, C_FG = 2208;
constexpr float EPS = 1e-6f, LOG2E = 1.4426950408889634f;

constexpr size_t O_Y = 0, O_CKVP = (size_t)NTOK * DM, O_KRP = O_CKVP + (size_t)NP * 256, O_FKP = O_KRP + (size_t)NP * 32, O_FVP = O_FKP + (size_t)NP * 512,
                 O_LFP = O_FVP + (size_t)NP * 512, O_CKVS = O_LFP + (size_t)NP * 8, O_KRS = O_CKVS + (size_t)NS * 256, O_FKS = O_KRS + (size_t)NS * 32,
                 O_FVS = O_FKS + (size_t)NS * 512, O_LFS = O_FVS + (size_t)NS * 512, O_END = O_LFS + (size_t)NS * 8;

constexpr size_t al256(size_t x) { return (x + 255) & ~(size_t)255; }
constexpr size_t WS_WGU1 = 0, WS_WD1 = WS_WGU1 + al256((size_t)NGU * DM * 2), WS_WGU2 = WS_WD1 + al256((size_t)DM * DFF * 2), WS_WD2 = WS_WGU2 + al256((size_t)NGU * DM * 2),
                 WS_WIN = WS_WD2 + al256((size_t)DM * DFF * 2), WS_WQ = WS_WIN + al256((size_t)NINP * DM * 2), WS_WKV = WS_WQ + al256((size_t)NQ * QLORA * 2),
                 WS_WO = WS_WKV + al256((size_t)NKV * KVLORA * 2), WS_TAB = WS_WO + al256((size_t)DM * DM * 2), WS_LK = WS_TAB + al256((size_t)SEQ * 16 * 8),
                 WS_LFS = WS_LK + al256((size_t)KPAD * 8 * 4), WS_KROPE = WS_LFS + al256((size_t)8 * SKEYS * 8 * 4), WS_XN = WS_KROPE + al256((size_t)KPAD * 32 * 2),
                 WS_D = WS_XN + al256((size_t)MPAD * DM * 2), WS_ACT = WS_D + al256((size_t)MPAD * DM * 2), WS_QM = WS_ACT + al256((size_t)MPAD * DFF * 2),
                 WS_KV = WS_QM + al256((size_t)MPAD * NQ * 2), WS_QCTR = WS_KV + al256((size_t)KPAD * NKV * 2), WS_BAR = WS_QCTR + 4096, WS_END = WS_BAR + 16384;
constexpr size_t WS_PROJ = WS_ACT, WS_CQN = WS_PROJ + al256((size_t)MPAD * NINP * 2);
constexpr size_t WS_CKVN = WS_D, WS_FKS = WS_CKVN + al256((size_t)KPAD * KVLORA * 2), WS_FVS = WS_FKS + al256((size_t)(8 * SKEYS + 64) * 512 * 2);
static_assert(WS_CQN + (size_t)MPAD * QLORA * 2 <= WS_QM, "overlay 1");
static_assert(WS_FVS + (size_t)(8 * SKEYS + 64) * 512 * 2 <= WS_ACT, "overlay 2");

constexpr int LDS_BYTES = 135168;

struct Args { const float* in[24]; float* out; unsigned char* ws; };
constexpr int PTR_OFF = 131072;
struct Ctx {
    LAS unsigned char* lds;
    __device__ __forceinline__ unsigned long long raw(int i) const { const unsigned long long v = *(const LAS unsigned long long*)(lds + PTR_OFF + 8 * i);
        const unsigned lo = __builtin_amdgcn_readfirstlane((unsigned)v), hi = __builtin_amdgcn_readfirstlane((unsigned)(v >> 32)); return ((unsigned long long)hi << 32) | lo; }
    __device__ __forceinline__ const float* in(int i) const { return (const float*)raw(i); }
    __device__ __forceinline__ float* out() const { return (float*)raw(24); }
    __device__ __forceinline__ unsigned char* ws() const { return (unsigned char*)raw(25); }
};
enum { I_XP = 0, I_XS, I_CCKV, I_CKR, I_CFK, I_CFV, I_CLF, I_G1PRE, I_G1POST, I_W1GU, I_W1D, I_GMPRE, I_GMPOST, I_WIN, I_BF, I_GQ, I_WQ, I_GKV, I_WKV, I_WO, I_G2PRE, I_G2POST, I_W2GU, I_W2D };

__device__ __forceinline__ unsigned f2bf(float f) { unsigned u = __builtin_bit_cast(unsigned, f); return (u + 0x7fffu + ((u >> 16) & 1u)) >> 16; }
__device__ __forceinline__ unsigned pk2(float lo, float hi) { return pg8::cvt_pk_bf16(lo, hi); }
__device__ __forceinline__ float bf2f(unsigned short b) { return __builtin_bit_cast(float, (unsigned)b << 16); }
__device__ __forceinline__ float bflo(unsigned w) { return __builtin_bit_cast(float, w << 16); }
__device__ __forceinline__ float bfhi(unsigned w) { return __builtin_bit_cast(float, w & 0xffff0000u); }
__device__ __forceinline__ float wave_sum(float v) {
#pragma unroll
    for (int o = 1; o < 64; o <<= 1) v += __shfl_xor(v, o);
    return v;
}
__device__ __forceinline__ int keyrow(int n) { return n < NP ? n : NP + ((n - NP) >> 4) * SKEYS + PAST + ((n - NP) & 15); }
__device__ __forceinline__ int rowpos(int n) { return n < NP ? (n & (SEQ - 1)) : PAST + ((n - NP) & 15); }

struct MapId  { __device__ __forceinline__ int col(int c) const { return c; } };
struct MapGU  { __device__ __forceinline__ int col(int c) const { return ((c >> 7) & 1) * DFF + (c >> 8) * 128 + (c & 127); } };
struct MapIn  { __device__ __forceinline__ int col(int c) const { return c < NIN ? c : -1; } };
struct MapQ   { __device__ __forceinline__ int col(int c) const { const int h = c / 96, w = c % 96; if (w < 64) return c; const int p = w - 64; return h * 96 + 64 + ((p & 1) ? (p >> 1) + 16 : (p >> 1)); } };
template <class Map> __device__ __forceinline__ void transpose_w(const float* W, int K, int Nsrc, bf16* WT, int Ndst, Map map, LAS float* scr, int gw, int NGW, int lane) {
    const int nblk = Ndst / 32, items = (K / 64) * nblk;
    for (int it = gw; it < items; it += NGW) {
        const int kb = it / nblk, nb = it % nblk, k0 = 64 * kb, n0 = 32 * nb;
        const int sc = map.col(n0 + (lane & 31));
#pragma unroll 8
        for (int i = 0; i < 32; ++i) { const int kk = 2 * i + (lane >> 5); scr[kk * 33 + (lane & 31)] = sc >= 0 ? W[(size_t)(k0 + kk) * Nsrc + sc] : 0.f; }
        asm volatile("s_waitcnt lgkmcnt(0)" ::: "memory");
        const int c = lane & 7;
#pragma unroll
        for (int j = 0; j < 4; ++j) { const int n = (lane >> 3) + 8 * j; const LAS float* s = scr + (8 * c) * 33 + n;
            u32x4 o; o.x = pk2(s[0 * 33], s[1 * 33]); o.y = pk2(s[2 * 33], s[3 * 33]); o.z = pk2(s[4 * 33], s[5 * 33]); o.w = pk2(s[6 * 33], s[7 * 33]);
            *(u32x4*)(WT + (size_t)(n0 + n) * K + k0 + 8 * c) = o; }
        asm volatile("s_waitcnt lgkmcnt(0)" ::: "memory");
    }
}
template <class Map> __device__ __forceinline__ void transpose_w4(const float* W, int K, int Nsrc, bf16* WT, int Ndst, Map map, LAS float* scr, int gw, int NGW, int lane) {
    const int nblk = Ndst / 32, items = (K / 64) * nblk;
    const int kq = lane >> 3, c4 = lane & 7;
    for (int it = gw; it < items; it += NGW) {
        const int kb = it / nblk, nb = it % nblk, k0 = 64 * kb, n0 = 32 * nb;
        const float* src = W + (size_t)(k0 + kq) * Nsrc + map.col(n0) + 4 * c4;
        f32x4 v[8];
#pragma unroll
        for (int i = 0; i < 8; ++i) v[i] = *(const GAS f32x4*)(src + (size_t)(8 * i) * Nsrc);
#pragma unroll
        for (int i = 0; i < 8; ++i) { LAS float* d = scr + (8 * i + kq) * 33 + 4 * c4; d[0] = v[i][0]; d[1] = v[i][1]; d[2] = v[i][2]; d[3] = v[i][3]; }
        asm volatile("s_waitcnt lgkmcnt(0)" ::: "memory");
        const int c = lane & 7;
#pragma unroll
        for (int j = 0; j < 4; ++j) { const int n = (lane >> 3) + 8 * j; const LAS float* s = scr + (8 * c) * 33 + n;
            u32x4 o; o.x = pk2(s[0 * 33], s[1 * 33]); o.y = pk2(s[2 * 33], s[3 * 33]); o.z = pk2(s[4 * 33], s[5 * 33]); o.w = pk2(s[6 * 33], s[7 * 33]);
            *(GAS u32x4*)(WT + (size_t)(n0 + n) * K + k0 + 8 * c) = o; }
        asm volatile("s_waitcnt lgkmcnt(0)" ::: "memory");
    }
}
__device__ __forceinline__ void rope_cs(int pos, int i, float& c, float& s) {
    double f = 1.0; for (int k = 0; k < i; ++k) f *= 0.56234132519034908;
    const double ang = (double)pos * f;
    const double q = __builtin_rint(ang * 0.63661977236758134);
    const double y = (ang - q * 1.5707963267948966) - q * 6.123233995736766e-17;
    const double y2 = y * y;
    const double sn = y * (1.0 + y2 * (-1.0 / 6 + y2 * (1.0 / 120 + y2 * (-1.0 / 5040 + y2 * (1.0 / 362880 + y2 * (-1.0 / 39916800 + y2 * (1.0 / 6227020800.0)))))));
    const double cs = 1.0 + y2 * (-0.5 + y2 * (1.0 / 24 + y2 * (-1.0 / 720 + y2 * (1.0 / 40320 + y2 * (-1.0 / 3628800 + y2 * (1.0 / 479001600 + y2 * (-1.0 / 87178291200.0)))))));
    const int qi = (int)((long long)q & 3);
    const double cc = (qi == 0) ? cs : (qi == 1) ? -sn : (qi == 2) ? -cs : sn;
    const double ss = (qi == 0) ? sn : (qi == 1) ? cs : (qi == 2) ? -sn : -cs;
    c = (float)cc; s = (float)ss;
}

__device__ __forceinline__ void load16_f32(const float* p, int lane, float (&v)[16]) {
#pragma unroll
    for (int j = 0; j < 2; ++j) { const f32x4 a = *(const f32x4*)(p + 8 * lane + 512 * j), b = *(const f32x4*)(p + 8 * lane + 512 * j + 4);
        v[8 * j + 0] = a[0]; v[8 * j + 1] = a[1]; v[8 * j + 2] = a[2]; v[8 * j + 3] = a[3]; v[8 * j + 4] = b[0]; v[8 * j + 5] = b[1]; v[8 * j + 6] = b[2]; v[8 * j + 7] = b[3]; }
}
__device__ __forceinline__ void load16_bf16(const bf16* p, int lane, float (&v)[16]) {
#pragma unroll
    for (int j = 0; j < 2; ++j) { const u32x4 a = *(const u32x4*)(p + 8 * lane + 512 * j);
        v[8 * j + 0] = bflo(a.x); v[8 * j + 1] = bfhi(a.x); v[8 * j + 2] = bflo(a.y); v[8 * j + 3] = bfhi(a.y); v[8 * j + 4] = bflo(a.z); v[8 * j + 5] = bfhi(a.z); v[8 * j + 6] = bflo(a.w); v[8 * j + 7] = bfhi(a.w); }
}
__device__ __forceinline__ void store16_f32(float* p, int lane, const float (&v)[16]) {
#pragma unroll
    for (int j = 0; j < 2; ++j) { *(f32x4*)(p + 8 * lane + 512 * j) = (f32x4){v[8 * j], v[8 * j + 1], v[8 * j + 2], v[8 * j + 3]}; *(f32x4*)(p + 8 * lane + 512 * j + 4) = (f32x4){v[8 * j + 4], v[8 * j + 5], v[8 * j + 6], v[8 * j + 7]}; }
}
__device__ __forceinline__ void store16_f32_nt(float* p, int lane, const float (&v)[16]) {
#pragma unroll
    for (int j = 0; j < 2; ++j) { __builtin_nontemporal_store((f32x4){v[8 * j], v[8 * j + 1], v[8 * j + 2], v[8 * j + 3]}, (f32x4*)(p + 8 * lane + 512 * j)); __builtin_nontemporal_store((f32x4){v[8 * j + 4], v[8 * j + 5], v[8 * j + 6], v[8 * j + 7]}, (f32x4*)(p + 8 * lane + 512 * j + 4)); }
}
__device__ __forceinline__ void store16_bf16(bf16* p, int lane, const float (&v)[16]) {
#pragma unroll
    for (int j = 0; j < 2; ++j) { u32x4 o; o.x = pk2(v[8 * j], v[8 * j + 1]); o.y = pk2(v[8 * j + 2], v[8 * j + 3]); o.z = pk2(v[8 * j + 4], v[8 * j + 5]); o.w = pk2(v[8 * j + 6], v[8 * j + 7]); *(u32x4*)(p + 8 * lane + 512 * j) = o; }
}
__device__ __forceinline__ float ssq16(const float (&v)[16]) { float s = 0.f;
#pragma unroll
    for (int i = 0; i < 16; ++i) s += v[i] * v[i];
    return wave_sum(s); }
__device__ __forceinline__ void rp_norm_only(const Ctx& a, const float* g, bf16* XN, int gw, int NGW, int lane) {
    float gv[16]; load16_f32(g, lane, gv); const float* xp = a.in(I_XP); const float* xs = a.in(I_XS);
    for (int n = gw; n < NTOK; n += NGW) {
        const float* xr = n < NP ? xp + (size_t)n * DM : xs + (size_t)(n - NP) * DM;
        float v[16]; load16_f32(xr, lane, v);
        const float rs = 1.0f / sqrtf(ssq16(v) * (1.0f / DM) + EPS);
#pragma unroll
        for (int i = 0; i < 16; ++i) v[i] = v[i] * rs * gv[i];
        store16_bf16(XN + (size_t)n * DM, lane, v);
    }
}
__device__ __forceinline__ void rp_residual(const Ctx& a, bool base_is_x, bool final_y, const bf16* D, float coef, const float* gpost, const float* gnext, float* hout, bf16* XN, int n0, int n1, int gw, int NGW, int lane) {
    const float* xp = a.in(I_XP); const float* xs = a.in(I_XS);
    float g[16], g2[16]; load16_f32(gpost, lane, g); if (gnext) load16_f32(gnext, lane, g2);
    for (int n = n0 + gw; n < n1; n += NGW) {
        float v[16], d[16];
        if (base_is_x) load16_f32(n < NP ? xp + (size_t)n * DM : xs + (size_t)(n - NP) * DM, lane, v); else load16_bf16((const bf16*)(hout + (size_t)n * DM), lane, v);
        load16_bf16(D + (size_t)n * DM, lane, d);
        const float rs = coef / sqrtf(ssq16(d) * (1.0f / DM) + EPS);
#pragma unroll
        for (int i = 0; i < 16; ++i) v[i] = v[i] + d[i] * rs * g[i];
        if (final_y) store16_f32_nt(hout + (size_t)n * DM, lane, v); else store16_bf16((bf16*)(hout + (size_t)n * DM), lane, v);
        if (gnext) {
            const float rs2 = 1.0f / sqrtf(ssq16(v) * (1.0f / DM) + EPS);
#pragma unroll
            for (int i = 0; i < 16; ++i) v[i] = v[i] * rs2 * g2[i];
            store16_bf16(XN + (size_t)n * DM, lane, v);
        }
    }
}
__device__ __forceinline__ void rp_mix(const Ctx& a, int n0, int n1, bool do_cache, int gw, int NGW, int lane) {
    unsigned char* ws = a.ws(); float* out = a.out();
    const bf16* PROJ = (const bf16*)(ws + WS_PROJ); bf16* CQN = (bf16*)(ws + WS_CQN); bf16* CKVN = (bf16*)(ws + WS_CKVN); bf16* KROPE = (bf16*)(ws + WS_KROPE);
    bf16* FKS = (bf16*)(ws + WS_FKS); bf16* FVS = (bf16*)(ws + WS_FVS); float* LFS = (float*)(ws + WS_LFS); const float* TAB = (const float*)(ws + WS_TAB);
    const float* gq = a.in(I_GQ); const float* gkv = a.in(I_GKV); const float* bfg = a.in(I_BF);
    float gqv[6];
#pragma unroll
    for (int i = 0; i < 6; ++i) gqv[i] = gq[6 * lane + i];
    const f32x4 gkvv = *(const f32x4*)(gkv + 4 * lane); const float bfv = bfg[lane & 7];
    for (int n = n0 + gw; n < n1; n += NGW) {
        const bf16* pr = PROJ + (size_t)n * NINP; const bool smp = n >= NP; const int ns = n - NP; const int kr = keyrow(n);
        { const unsigned* p = (const unsigned*)(pr + 6 * lane); const unsigned w0 = p[0], w1 = p[1], w2 = p[2];
          float v[6] = {bflo(w0), bfhi(w0), bflo(w1), bfhi(w1), bflo(w2), bfhi(w2)}; float s = 0.f;
#pragma unroll
          for (int i = 0; i < 6; ++i) s += v[i] * v[i];
          const float rs = 1.0f / sqrtf(wave_sum(s) * (1.0f / QLORA) + EPS);
#pragma unroll
          for (int i = 0; i < 6; ++i) v[i] = v[i] * rs * gqv[i];
          unsigned* o = (unsigned*)(CQN + (size_t)n * QLORA + 6 * lane); o[0] = pk2(v[0], v[1]); o[1] = pk2(v[2], v[3]); o[2] = pk2(v[4], v[5]); }
        { const u32x2 w = *(const u32x2*)(pr + C_CKV + 4 * lane); float v[4] = {bflo(w.x), bfhi(w.x), bflo(w.y), bfhi(w.y)};
          const float rs = 1.0f / sqrtf(wave_sum(v[0] * v[0] + v[1] * v[1] + v[2] * v[2] + v[3] * v[3]) * (1.0f / KVLORA) + EPS);
          const f32x4 g = gkvv; const f32x4 r = {v[0] * rs * g[0], v[1] * rs * g[1], v[2] * rs * g[2], v[3] * rs * g[3]};
          __builtin_nontemporal_store(r, (f32x4*)(out + (smp ? O_CKVS + (size_t)ns * 256 : O_CKVP + (size_t)n * 256) + 4 * lane));
          u32x2 o; o.x = pk2(r[0], r[1]); o.y = pk2(r[2], r[3]); *(u32x2*)(CKVN + (size_t)kr * KVLORA + 4 * lane) = o; }
        if (lane < 16) { const float x1 = bf2f(pr[C_KR + lane]), x2 = bf2f(pr[C_KR + 16 + lane]); const int pos = rowpos(n);
          const float c = TAB[((size_t)pos * 16 + lane) * 2], s = TAB[((size_t)pos * 16 + lane) * 2 + 1];
          const float o1 = x1 * c - x2 * s, o2 = x1 * s + x2 * c; float* kr_out = out + (smp ? O_KRS + (size_t)ns * 32 : O_KRP + (size_t)n * 32);
          kr_out[lane] = o1; kr_out[16 + lane] = o2; *(unsigned*)(KROPE + (size_t)kr * 32 + 2 * lane) = pk2(o1, o2); }
        { const u32x4 wk = *(const u32x4*)(pr + C_FK + 8 * lane), wv = *(const u32x4*)(pr + C_FV + 8 * lane);
          float* ko = out + (smp ? O_FKS + (size_t)ns * 512 : O_FKP + (size_t)n * 512) + 8 * lane; float* vo = out + (smp ? O_FVS + (size_t)ns * 512 : O_FVP + (size_t)n * 512) + 8 * lane;
          __builtin_nontemporal_store((f32x4){bflo(wk.x), bfhi(wk.x), bflo(wk.y), bfhi(wk.y)}, (f32x4*)ko); __builtin_nontemporal_store((f32x4){bflo(wk.z), bfhi(wk.z), bflo(wk.w), bfhi(wk.w)}, (f32x4*)(ko + 4));
          __builtin_nontemporal_store((f32x4){bflo(wv.x), bfhi(wv.x), bflo(wv.y), bfhi(wv.y)}, (f32x4*)vo); __builtin_nontemporal_store((f32x4){bflo(wv.z), bfhi(wv.z), bflo(wv.w), bfhi(wv.w)}, (f32x4*)(vo + 4));
          if (smp) { *(u32x4*)(FKS + (size_t)(kr - NP) * 512 + 8 * lane) = wk; *(u32x4*)(FVS + (size_t)(kr - NP) * 512 + 8 * lane) = wv; } }
        if (lane < 8) { const float z = bf2f(pr[C_FG + lane]) + bfv; const float lf = fminf(z, 0.f) - log1pf(expf(-fabsf(z)));
          out[(smp ? O_LFS + (size_t)ns * 8 : O_LFP + (size_t)n * 8) + lane] = lf; if (smp) LFS[(size_t)(kr - NP) * 8 + lane] = lf; }
    }
    if (!do_cache) return;
    int lane_ = lane; asm volatile("" : "+v"(lane_));
    const unsigned gt = (unsigned)gw * 64u + (unsigned)lane_, NT = (unsigned)NGW * 64u;
    { const float* src = a.in(I_CCKV);
      for (unsigned e = gt; e < 8u * PAST * 256 / 8; e += NT) { const unsigned row = e >> 5, c = (e & 31) * 8; const unsigned b = row >> 12, j = row & 4095;
        const f32x4 x = *(const f32x4*)(src + (size_t)row * 256 + c), y = *(const f32x4*)(src + (size_t)row * 256 + c + 4);
        u32x4 o; o.x = pk2(x[0], x[1]); o.y = pk2(x[2], x[3]); o.z = pk2(y[0], y[1]); o.w = pk2(y[2], y[3]); *(u32x4*)(CKVN + ((size_t)NP + b * SKEYS + j) * 256 + c) = o; } }
    { const float* srck = a.in(I_CFK); const float* srcv = a.in(I_CFV);
      for (unsigned e = gt; e < 8u * PAST * 512 / 8; e += NT) { const unsigned row = e >> 6, c = (e & 63) * 8; const unsigned b = row >> 12, j = row & 4095;
        f32x4 x = *(const f32x4*)(srck + (size_t)row * 512 + c), y = *(const f32x4*)(srck + (size_t)row * 512 + c + 4);
        u32x4 o; o.x = pk2(x[0], x[1]); o.y = pk2(x[2], x[3]); o.z = pk2(y[0], y[1]); o.w = pk2(y[2], y[3]); *(u32x4*)(FKS + (size_t)(b * SKEYS + j) * 512 + c) = o;
        x = *(const f32x4*)(srcv + (size_t)row * 512 + c); y = *(const f32x4*)(srcv + (size_t)row * 512 + c + 4);
        o.x = pk2(x[0], x[1]); o.y = pk2(x[2], x[3]); o.z = pk2(y[0], y[1]); o.w = pk2(y[2], y[3]); *(u32x4*)(FVS + (size_t)(b * SKEYS + j) * 512 + c) = o; } }
    { const float* src = a.in(I_CKR);
      for (unsigned e = gt; e < 8u * PAST * 16; e += NT) { const unsigned row = e >> 4, i = e & 15; const unsigned b = row >> 12, j = row & 4095;
        *(unsigned*)(KROPE + ((size_t)NP + b * SKEYS + j) * 32 + 2 * i) = pk2(src[(size_t)row * 32 + i], src[(size_t)row * 32 + 16 + i]); } }
    { const float* src = a.in(I_CLF);
      for (unsigned e = gt; e < 8u * PAST * 8; e += NT) { const unsigned row = e >> 3, h = e & 7; const unsigned b = row >> 12, j = row & 4095; LFS[(size_t)(b * SKEYS + j) * 8 + h] = src[e]; } }
}
__device__ __forceinline__ void scan_item(const float* src, float* dst, int len, LAS float* sm, int tid) {
    const int per = (len + 511) / 512, i0 = tid * per, i1 = min(len, i0 + per);
    float s = 0.f; for (int i = i0; i < i1; ++i) s += src[(size_t)i * 8];
    const int lane = tid & 63, wid = tid >> 6; float inc = s;
#pragma unroll
    for (int o = 1; o < 64; o <<= 1) { const float t = __shfl_up(inc, o); if (lane >= o) inc += t; }
    __syncthreads();
    if (lane == 63) sm[wid] = inc;
    __syncthreads();
    float pre = 0.f; for (int w = 0; w < wid; ++w) pre += sm[w];
    float run = pre + inc - s;
    for (int i = i0; i < i1; ++i) { run += src[(size_t)i * 8]; dst[(size_t)i * 8] = run; }
}

struct AttnUnit { const bf16* Q; const bf16* K; const bf16* KR; const bf16* V; const float* LK; const float* TAB; bf16* O; int qpitch, kpitch, vpitch, nkeys, qpos0, nq; };
constexpr int A_KP = 208, A_VP = 192, A_KB = 64 * A_KP, A_VB = 64 * A_VP, A_STG = A_KB + A_VB + 256, A_WS = 2 * A_STG;
__device__ __forceinline__ int crow(int r, int hi) { return (r & 3) + 8 * (r >> 2) + 4 * hi; }
typedef float f32x2_t __attribute__((ext_vector_type(2))); typedef __bf16 bf16x2_t __attribute__((ext_vector_type(2)));
__device__ __forceinline__ unsigned cvtpk(float lo, float hi) { f32x2_t v = {lo, hi}; bf16x2_t b = __builtin_convertvector(v, bf16x2_t); return __builtin_bit_cast(unsigned, b); }
#define MX3(a, b, c) __builtin_fmaxf(__builtin_fmaxf((a), (b)), (c))
template <int TYPE> __device__ __forceinline__ void attn_unit(LAS unsigned char* lds, const AttnUnit& U) {
    constexpr int ND = TYPE == 0 ? 6 : 4;
    constexpr float SC = (TYPE == 0 ? 0.10206207261596575f : 0.125f) * LOG2E;
    constexpr float THR = 40.0f;
    int tid_ = threadIdx.x; asm volatile("" : "+v"(tid_));
    const int tid = tid_, lane = tid & 63, wid = __builtin_amdgcn_readfirstlane(tid >> 6), r32 = lane & 31, hi = lane >> 5;
    const int NT = (U.qpos0 + (U.nq > 32 ? 256 : 32) - 1) / 64 + 1;
    const bool active = wid * 32 < U.nq;
    const int NTw = active ? (U.qpos0 + 32 * wid + 31) / 64 + 1 : 0;
    LAS float* wsf = (LAS float*)(lds + 82944) + wid * 64;
#define A_KS(s) ((s) * 12288)
#define A_VS(s) (49152 + (s) * 8192)
#define A_BS(s) (81920 + (s) * 256)
    const unsigned lds0 = (unsigned)(uintptr_t)lds;
    const int lastrow = U.nkeys - 1 - 64 * (NT - 1);
    const int lr8 = 8 * wid + (lane >> 3);
    const int kch = (lane & 7) ^ ((4 * wid + (lane >> 4)) & 7);
    const int vch = (lane & 7) ^ (((lane >> 4) & 1) * 4);
    const int rr16 = 16 * (wid & 3) + (lane >> 2), rch = (lane & 3) ^ ((lane >> 4) & 3);
    const unsigned voK = (unsigned)(lr8 * U.kpitch * 2 + 16 * kch), voKl = (unsigned)(min(lr8, lastrow) * U.kpitch * 2 + 16 * kch);
    const unsigned voV = (unsigned)(lr8 * U.vpitch * 2 + 16 * vch), voVl = (unsigned)(min(lr8, lastrow) * U.vpitch * 2 + 16 * vch);
    const unsigned voA = TYPE == 0 ? (unsigned)(rr16 * 64 + 16 * rch) : (unsigned)(lane * 32), voAl = TYPE == 0 ? (unsigned)(min(rr16, lastrow) * 64 + 16 * rch) : (unsigned)(min(lane, lastrow) * 32);
#define A_DMA16(vo, sb, dst) do { unsigned keep_; asm volatile("s_mov_b32 %0, m0\n\ts_mov_b32 m0, %3\n\ts_nop 0\n\tglobal_load_lds_dwordx4 %1, %2\n\ts_mov_b32 m0, %0" : "=&s"(keep_) : "v"(vo), "s"(sb), "s"(dst) : "memory"); } while (0)
#define A_DMA4(vo, sb, dst) do { unsigned keep_; asm volatile("s_mov_b32 %0, m0\n\ts_mov_b32 m0, %3\n\ts_nop 0\n\tglobal_load_lds_dword %1, %2\n\ts_mov_b32 m0, %0" : "=&s"(keep_) : "v"(vo), "s"(sb), "s"(dst) : "memory"); } while (0)
#define A_DMAK(t, slot) do { const int tc_ = min((int)(t), NT - 1); const bool l_ = tc_ == NT - 1; \
        const bf16* kb_ = U.K + (size_t)(64 * tc_) * U.kpitch; \
        A_DMA16(l_ ? voKl : voK, kb_, (unsigned)__builtin_amdgcn_readfirstlane(lds0 + A_KS(slot) + wid * 1024)); \
        if (TYPE == 0) { const bf16* rb_ = U.KR + (size_t)(64 * tc_) * 32; A_DMA16(l_ ? voAl : voA, rb_, (unsigned)__builtin_amdgcn_readfirstlane(lds0 + A_KS(slot) + 8192 + (wid & 3) * 1024)); } \
        else { const float* bb_ = U.LK + (size_t)(64 * tc_) * 8; A_DMA4(l_ ? voAl : voA, bb_, (unsigned)__builtin_amdgcn_readfirstlane(lds0 + A_BS(slot))); } } while (0)
#define A_DMAV(t, slot) do { const int tc_ = min((int)(t), NT - 1); const bool l_ = tc_ == NT - 1; const bf16* vb_ = U.V + (size_t)(64 * tc_) * U.vpitch; \
        A_DMA16(l_ ? voVl : voV, vb_, (unsigned)__builtin_amdgcn_readfirstlane(lds0 + A_VS(slot) + wid * 1024)); } while (0)
#define A_SB() __builtin_amdgcn_sched_barrier(0)
#define A_PINW() asm volatile("" : "+v"(pw[0]), "+v"(pw[1]), "+v"(pw[2]), "+v"(pw[3]))
#define A_PINP() asm volatile("" : "+v"(p0), "+v"(p1))
#define A_PK1(c) do { if ((c) < 16) { const int i_ = 2 * (c); pw[(c) >> 2][(c) & 3] = cvtpk(i_ < 16 ? p0[i_ & 15] : p1[i_ & 15], i_ < 16 ? p0[(i_ + 1) & 15] : p1[(i_ + 1) & 15]); } } while (0)
    unsigned kad[ND];
#pragma unroll
    for (int d0 = 0; d0 < ND; ++d0) kad[d0] = lds0 + (d0 < 4 ? r32 * 128 + 16 * ((2 * d0 + hi) ^ ((r32 >> 1) & 7)) : 8192 + r32 * 64 + 16 * ((2 * (d0 - 4) + hi) ^ ((r32 >> 2) & 3)));
    const int vq_ = (lane & 15) >> 2, vp_ = lane & 3, vsw_ = ((vq_ >> 1) & 1) * 4, vck_ = 2 * ((lane >> 4) & 1) + (vp_ >> 1);
    const unsigned vad0 = lds0 + (4 * hi + vq_) * 128 + 16 * (vck_ ^ vsw_) + 8 * (vp_ & 1), vad1 = lds0 + (4 * hi + vq_) * 128 + 16 * ((4 + vck_) ^ vsw_) + 8 * (vp_ & 1);
    const unsigned bad = lds0 + 16 * hi;
#define A_LDK(d0, half) (*(const LAS bf16x8*)(uintptr_t)(kcur[d0] + (half) * ((d0) < 4 ? 32 * 128 : 32 * 64)))
#define A_QKPRE(SK, s0, s1) \
        unsigned kcur[ND]; \
        _Pragma("unroll") for (int d0 = 0; d0 < ND; ++d0) kcur[d0] = kad[d0] + (unsigned)A_KS(SK); \
        if (TYPE == 1) { const float nm_ = -mref; const unsigned bcur = bad + (unsigned)A_BS(SK); \
            _Pragma("unroll") for (int g = 0; g < 4; ++g) { const f32x4 b0 = *(const LAS f32x4*)(uintptr_t)(bcur + 32 * g), b1 = *(const LAS f32x4*)(uintptr_t)(bcur + 128 + 32 * g); \
                _Pragma("unroll") for (int i = 0; i < 4; ++i) { s0[4 * g + i] = __builtin_fmaf(b0[i], -LOG2E, nm_); s1[4 * g + i] = __builtin_fmaf(b1[i], -LOG2E, nm_); } } \
        } else { s0 = negm; s1 = negm; } \
        bf16x8 ka0 = A_LDK(0, 0), ka1 = A_LDK(0, 1);
#define A_QK(SK, s0, s1, PACK) do { \
        A_SB(); \
        _Pragma("unroll") for (int d0 = 0; d0 < ND; ++d0) { \
            bf16x8 kn0 = ka0, kn1 = ka1; \
            if (d0 + 1 < ND) { kn0 = A_LDK((d0 + 1 < ND ? d0 + 1 : 0), 0); kn1 = A_LDK((d0 + 1 < ND ? d0 + 1 : 0), 1); } \
            s0 = __builtin_amdgcn_mfma_f32_32x32x16_bf16(ka0, qf[d0], s0, 0, 0, 0); \
            if (PACK) { A_PK1(4 * d0); A_PK1(4 * d0 + 1); A_PINW(); } \
            A_SB(); \
            s1 = __builtin_amdgcn_mfma_f32_32x32x16_bf16(ka1, qf[d0], s1, 0, 0, 0); \
            if (PACK) { A_PK1(4 * d0 + 2); A_PK1(4 * d0 + 3); A_PINW(); } \
            A_SB(); \
            ka0 = kn0; ka1 = kn1; } } while (0)
#define A_PACK() do { _Pragma("unroll") for (int c = 0; c < 16; ++c) A_PK1(c); } while (0)
#define A_MASK(t, s0, s1) do { const int qpos = U.qpos0 + 32 * wid + r32; \
        _Pragma("unroll") for (int r = 0; r < 16; ++r) { const int kv = 64 * (t) + crow(r, hi); \
            if (!(kv < U.nkeys && (TYPE == 0 || kv <= qpos))) s0[r] = -INFINITY; \
            if (!(kv + 32 < U.nkeys && (TYPE == 0 || kv + 32 <= qpos))) s1[r] = -INFINITY; } } while (0)
#define A_ROWMAX(s0, s1, mt) do { float ma = MX3(s0[0], s0[1], s1[0]), mb = MX3(s0[2], s0[3], s1[1]); ma = MX3(ma, s1[2], s1[3]); \
        _Pragma("unroll") for (int r = 4; r < 16; r += 4) { ma = MX3(ma, s0[r], s0[r + 1]); mb = MX3(mb, s0[r + 2], s0[r + 3]); ma = MX3(ma, s1[r], s1[r + 1]); mb = MX3(mb, s1[r + 2], s1[r + 3]); } \
        mt = fmaxf(ma, mb); { const auto rr_ = __builtin_amdgcn_permlane32_swap(__float_as_uint(mt), __float_as_uint(mt), false, false); mt = fmaxf(__uint_as_float(rr_[0]), __uint_as_float(rr_[1])); } } while (0)
#define A_TR(a) __builtin_bit_cast(s16x4, __builtin_amdgcn_ds_read_tr16_b64_v4i16((LAS s16x4*)(uintptr_t)(a)))
#define A_VRD(dst0, dst1, kk_, SV) do { const int kvb_ = 32 * ((kk_) >> 1) + 16 * ((kk_) & 1); \
        const s16x4 l0_ = A_TR(vcur0 + kvb_ * 128), h0_ = A_TR(vcur0 + (kvb_ + 8) * 128), l1_ = A_TR(vcur1 + kvb_ * 128), h1_ = A_TR(vcur1 + (kvb_ + 8) * 128); \
        dst0 = (bf16x8){l0_[0], l0_[1], l0_[2], l0_[3], h0_[0], h0_[1], h0_[2], h0_[3]}; dst1 = (bf16x8){l1_[0], l1_[1], l1_[2], l1_[3], h1_[0], h1_[1], h1_[2], h1_[3]}; } while (0)
#define A_EX0(r, sv) p0[r] = __builtin_amdgcn_exp2f(sv[r])
#define A_EX1(r, sv) p1[r] = __builtin_amdgcn_exp2f(sv[r])
#define A_PV(SV, EXPS, s0, s1) do { \
        const unsigned vcur0 = vad0 + (unsigned)A_VS(SV), vcur1 = vad1 + (unsigned)A_VS(SV); \
        bf16x8 va0, va1; A_VRD(va0, va1, 0, SV); \
        A_SB(); \
        _Pragma("unroll") for (int kk = 0; kk < 4; ++kk) { \
            const bf16x8 pk_ = __builtin_bit_cast(bf16x8, pw[kk]); \
            bf16x8 vn0 = va0, vn1 = va1; \
            o2 = __builtin_amdgcn_mfma_f32_32x32x16_bf16(pk_, ones, o2, 0, 0, 0); \
            if (EXPS) { A_EX0(4 * kk, s0); A_EX0(4 * kk + 1, s0); A_EX1(4 * kk, s1); A_PINP(); } \
            if (kk + 1 < 4) A_VRD(vn0, vn1, kk + 1, SV); \
            A_SB(); \
            o0 = __builtin_amdgcn_mfma_f32_32x32x16_bf16(pk_, va0, o0, 0, 0, 0); \
            if (EXPS) { A_EX0(4 * kk + 2, s0); A_EX1(4 * kk + 1, s1); A_EX1(4 * kk + 2, s1); A_PINP(); } \
            A_SB(); \
            o1 = __builtin_amdgcn_mfma_f32_32x32x16_bf16(pk_, va1, o1, 0, 0, 0); \
            if (EXPS) { A_EX0(4 * kk + 3, s0); A_EX1(4 * kk + 3, s1); A_PINP(); } \
            A_SB(); \
            va0 = vn0; va1 = vn1; } } while (0)
    float mref = 0.f;
    f32x16 o0 = {}, o1 = {}, o2 = {}, negm = {}, p0 = {}, p1 = {};
    u32x4 pw[4] = {};
    const bf16x8 ones = {0x3F80, 0x3F80, 0x3F80, 0x3F80, 0x3F80, 0x3F80, 0x3F80, 0x3F80};
#define A_WAITBAR(n) asm volatile("s_waitcnt vmcnt(" #n ") lgkmcnt(0)\n\ts_barrier" ::: "memory")
    A_DMAK(0, 0); A_DMAK(1, 1); A_DMAV(0, 0);
    bf16x8 qf[ND];
    { int qrow = wid * 32 + r32; if (qrow >= U.nq) qrow = U.nq - 1;
      const bf16* qp = U.Q + (size_t)qrow * U.qpitch + hi * 8;
#pragma unroll
      for (int d0 = 0; d0 < ND; ++d0) qf[d0] = *(const GAS bf16x8*)(qp + d0 * 16);
#pragma unroll
      for (int d0 = 0; d0 < ND; ++d0) {
          u32x4 w = __builtin_bit_cast(u32x4, qf[d0]);
          if (TYPE == 0 && d0 >= 4) {
              const float* tb = U.TAB + (size_t)(U.qpos0 + qrow) * 32; const int pb = 8 * (d0 - 4) + 4 * hi; const f32x4 t0 = *(const GAS f32x4*)(tb + 2 * pb), t1 = *(const GAS f32x4*)(tb + 2 * pb + 4);
              { const float x1 = bflo(w.x), x2 = bfhi(w.x); w.x = cvtpk((x1 * t0[0] - x2 * t0[1]) * SC, (x1 * t0[1] + x2 * t0[0]) * SC); }
              { const float x1 = bflo(w.y), x2 = bfhi(w.y); w.y = cvtpk((x1 * t0[2] - x2 * t0[3]) * SC, (x1 * t0[3] + x2 * t0[2]) * SC); }
              { const float x1 = bflo(w.z), x2 = bfhi(w.z); w.z = cvtpk((x1 * t1[0] - x2 * t1[1]) * SC, (x1 * t1[1] + x2 * t1[0]) * SC); }
              { const float x1 = bflo(w.w), x2 = bfhi(w.w); w.w = cvtpk((x1 * t1[2] - x2 * t1[3]) * SC, (x1 * t1[3] + x2 * t1[2]) * SC); }
          } else { w.x = cvtpk(bflo(w.x) * SC, bfhi(w.x) * SC); w.y = cvtpk(bflo(w.y) * SC, bfhi(w.y) * SC); w.z = cvtpk(bflo(w.z) * SC, bfhi(w.z) * SC); w.w = cvtpk(bflo(w.w) * SC, bfhi(w.w) * SC); }
          qf[d0] = __builtin_bit_cast(bf16x8, w); } }
    A_WAITBAR(0);
#define A_TOP(t, d1_, d2_) do { if ((((t)) & 1) == 0) { A_DMAK((t) + 2, ((t) + 2) & 3); A_DMAK((t) + 3, ((t) + 3) & 3); A_DMAV((t) + 1, ((t) + 1) & 3); A_DMAV((t) + 2, ((t) + 2) & 3); } } while (0)
#define A_BOT() do { if (t & 1) { A_WAITBAR(0); } } while (0)
    int t = 0, sk = 0, sk2 = 3;
    const int sk1 = 0; (void)sk1;
#define A_ROT() do { sk = (t + 1) & 3; sk2 = t & 3; } while (0)
    {
        if (NTw > 0) {
            f32x16 s0, s1;
            A_QKPRE(sk, s0, s1)
            A_TOP(0, sk2, sk1);
            A_QK(sk, s0, s1, false);
            if (NTw == 1) A_MASK(0, s0, s1);
            float mt; A_ROWMAX(s0, s1, mt);
            mref = mt;
#pragma unroll
            for (int r = 0; r < 16; ++r) { if (TYPE == 0) negm[r] = -mref; p0[r] = __builtin_amdgcn_exp2f(s0[r] - mt); p1[r] = __builtin_amdgcn_exp2f(s1[r] - mt); }
        } else { A_TOP(0, sk2, sk1); }
        A_BOT(); A_ROT();
    }
    for (t = 1; t < NTw; ++t) {
        f32x16 s0, s1;
        A_QKPRE(sk, s0, s1)
        A_TOP(t, sk2, sk1);
        A_QK(sk, s0, s1, true);
        if (t == NTw - 1) A_MASK(t, s0, s1);
        float mt; A_ROWMAX(s0, s1, mt);
        bool resc = false;
        if (__any(mt > THR)) {
            const float dl = fmaxf(mt, 0.f); mref += dl;
#pragma unroll
            for (int r = 0; r < 16; ++r) { s0[r] -= dl; s1[r] -= dl; if (TYPE == 0) negm[r] = -mref; }
            if (hi == 0) wsf[r32] = __builtin_amdgcn_exp2f(-dl);
            resc = true;
        }
        A_PV(sk2, true, s0, s1);
        if (resc) {
            asm volatile("s_waitcnt lgkmcnt(0)" ::: "memory");
#pragma unroll
            for (int g = 0; g < 4; ++g) { const f32x4 al = *(const LAS f32x4*)(wsf + 8 * g + 4 * hi);
#pragma unroll
                for (int i = 0; i < 4; ++i) { o0[4 * g + i] *= al[i]; o1[4 * g + i] *= al[i]; o2[4 * g + i] *= al[i]; } }
            asm volatile("s_waitcnt lgkmcnt(0)" ::: "memory");
        }
        A_BOT(); A_ROT();
    }
    if (NTw > 0) {
        A_TOP(t, sk2, sk1);
        A_PACK();
        A_PV(sk2, false, p0, p1);
        A_BOT(); A_ROT();
        ++t;
    }
    for (; t <= NT; ++t) { A_TOP(t, sk2, sk1); A_BOT(); A_ROT(); }
    asm volatile("s_waitcnt vmcnt(0)" ::: "memory");
    if (active) {
#pragma unroll
        for (int r = 0; r < 16; ++r) { const int q = wid * 32 + crow(r, hi);
            if (q < U.nq) { const float il = __builtin_amdgcn_rcpf(o2[r]); GAS bf16* op = (GAS bf16*)(U.O + (size_t)q * DM + r32); op[0] = (bf16)f2bf(o0[r] * il); op[32] = (bf16)f2bf(o1[r] * il); } }
    }
    __syncthreads();
#undef A_KS
#undef A_VS
#undef A_BS
#undef A_DMA16
#undef A_DMA4
#undef A_DMAK
#undef A_DMAV
#undef A_SB
#undef A_PINW
#undef A_PINP
#undef A_PK1
#undef A_LDK
#undef A_QKPRE
#undef A_QK
#undef A_PACK
#undef A_MASK
#undef A_ROWMAX
#undef A_TR
#undef A_VRD
#undef A_EX0
#undef A_EX1
#undef A_PV
#undef A_WAITBAR
#undef A_TOP
#undef A_BOT
#undef A_ROT
}
__device__ __forceinline__ void attn_phase(const Ctx& a, LAS unsigned char* lds) {
    unsigned char* ws = a.ws();
    const bf16* PROJ = (const bf16*)(ws + WS_PROJ); const bf16* QM = (const bf16*)(ws + WS_QM); const bf16* KV = (const bf16*)(ws + WS_KV); const bf16* KROPE = (const bf16*)(ws + WS_KROPE);
    const bf16* FKS = (const bf16*)(ws + WS_FKS); const bf16* FVS = (const bf16*)(ws + WS_FVS); const float* LKB = (const float*)(ws + WS_LK); bf16* OB = (bf16*)(ws + WS_XN);
    unsigned* qctr = (unsigned*)(ws + WS_QCTR);
    const int myx = (int)(__builtin_amdgcn_s_getreg((3 << 11) | 20) & 7u);
    LAS int* slot = (LAS int*)(lds + PTR_OFF + 256);
    int qoff = 0;
    for (;;) {
        if (threadIdx.x == 0) {
            int e = -1, x = 0;
            while (qoff < 8) { x = (myx + qoff) & 7; const unsigned v = atomicAdd(qctr + 64 * x, 1u); if (v < 272u) { e = (int)v; break; } ++qoff; }
            slot[0] = e; slot[1] = x;
        }
        __syncthreads();
        const int e = slot[0], x = slot[1];
        __syncthreads();
        if (e < 0) break;
        const int nhalf = e < 256 ? 2 : 1;
        for (int half = 0; half < nhalf; ++half) {
            AttnUnit U; int type; U.TAB = (const float*)(ws + WS_TAB);
            if (e < 256) {
                const int ks = e >> 4, jj = e & 15;
                const int s = x + 8 * ks; type = s >> 6; const int b = (s >> 3) & 7, h = s & 7, qb = half ? 31 - jj : jj; const size_t r0 = (size_t)b * SEQ, q0 = r0 + 256 * qb;
                U.nkeys = SEQ; U.qpos0 = 256 * qb; U.nq = 256;
                if (type == 0) { U.Q = QM + q0 * NQ + 96 * h; U.qpitch = NQ; U.K = KV + r0 * NKV + 128 * h; U.kpitch = NKV; U.KR = KROPE + r0 * 32; U.V = KV + r0 * NKV + 128 * h + 64; U.vpitch = NKV; U.LK = nullptr; U.O = OB + q0 * DM + 64 * h; }
                else { U.Q = PROJ + q0 * NINP + C_FQ + 64 * h; U.qpitch = NINP; U.K = PROJ + r0 * NINP + C_FK + 64 * h; U.kpitch = NINP; U.KR = nullptr; U.V = PROJ + r0 * NINP + C_FV + 64 * h; U.vpitch = NINP; U.LK = LKB + r0 * 8 + h; U.O = OB + q0 * DM + 512 + 64 * h; }
            } else {
                const int j = e - 256; type = j >> 3; const int b = j & 7, h = x; const size_t q0 = (size_t)NP + 16 * b, r0 = (size_t)NP + (size_t)b * SKEYS;
                U.nkeys = SKEYS; U.qpos0 = PAST; U.nq = DSEQ;
                if (type == 0) { U.Q = QM + q0 * NQ + 96 * h; U.qpitch = NQ; U.K = KV + r0 * NKV + 128 * h; U.kpitch = NKV; U.KR = KROPE + r0 * 32; U.V = KV + r0 * NKV + 128 * h + 64; U.vpitch = NKV; U.LK = nullptr; U.O = OB + q0 * DM + 64 * h; }
                else { U.Q = PROJ + q0 * NINP + C_FQ + 64 * h; U.qpitch = NINP; U.K = FKS + (size_t)b * SKEYS * 512 + 64 * h; U.kpitch = 512; U.KR = nullptr; U.V = FVS + (size_t)b * SKEYS * 512 + 64 * h; U.vpitch = 512; U.LK = LKB + r0 * 8 + h; U.O = OB + q0 * DM + 512 + 64 * h; }
            }
            if (type == 0) attn_unit<0>(lds, U); else attn_unit<1>(lds, U);
        }
    }
}

template <class Epi> __device__ __forceinline__ void run_gemm(LAS unsigned char* lds, const bf16* A, const bf16* Bt, int M, int N, int K, const Epi& E) {
    pg8::Gemm g{A, Bt, M, N, K}; pg8::StaticOrder S; S.init(M, N, (int)gridDim.x, (int)blockIdx.x);
    pg8::gemm_phase<Epi, pg8::StaticOrder, true, true>(lds, g, S, E);
}
#define XB_TMO      128
#define XB_XCNT(j)  (256  + 64 * (j))
#define XB_XSUB(j)  (1280 + 64 * (j))
#define XB_XGEN(j)  (2304 + 64 * (j))
#define XB_TOP      3328
#define XB_TOPGEN   3392
#define XCD_BAR_WORDS 3456
#define XB_SPIN_CAP (1u << 18)

__device__ __forceinline__ unsigned xb_ld(unsigned* p)              { return __hip_atomic_load(p, __ATOMIC_RELAXED, __HIP_MEMORY_SCOPE_AGENT); }
__device__ __forceinline__ unsigned xb_add(unsigned* p, unsigned v) { return __hip_atomic_fetch_add(p, v, __ATOMIC_RELAXED, __HIP_MEMORY_SCOPE_AGENT); }
__device__ __forceinline__ unsigned xb_xcc_id() { return (unsigned)__builtin_amdgcn_s_getreg((3 << 11) | 20) & 0xFu; }
#define XB_SPIN(cond, bar) do { unsigned _sp = 0; while (cond) { __builtin_amdgcn_s_sleep(1); \
    if ((++_sp & 255u) == 0u) { if (xb_ld(&(bar)[XB_TMO])) break; if (_sp > XB_SPIN_CAP) { atomicAdd(&(bar)[XB_TMO], 1u); break; } } } } while (0)

struct XcdBarrier {
    unsigned* bar; unsigned x;
    volatile LAS unsigned* st;
};

__device__ __forceinline__ XcdBarrier xcd_barrier_post(unsigned* bar, volatile LAS unsigned* st) {
    XcdBarrier b; b.bar = bar; b.x = xb_xcc_id(); b.st = st;
    if (threadIdx.x == 0) (void)xb_add(&bar[XB_XCNT(b.x)], 1u);
    return b;
}
__device__ __forceinline__ void xcd_barrier_complete(unsigned* bar, unsigned x, unsigned& nloc, unsigned& nx) {
    const unsigned G = gridDim.x * gridDim.y * gridDim.z;
    unsigned sum, cnt, mine, sp = 0u;
    for (;;) {
        sum = 0u; cnt = 0u; mine = 0u;
#pragma unroll
        for (unsigned j = 0; j < 16; ++j) { const unsigned c = xb_ld(&bar[XB_XCNT(j)]); sum += c; cnt += (c > 0u) ? 1u : 0u; mine = (j == x) ? c : mine; }
        if (sum == G) break;
        __builtin_amdgcn_s_sleep(1);
        if ((++sp & 255u) == 0u) { if (xb_ld(&bar[XB_TMO])) break; if (sp > XB_SPIN_CAP) { atomicAdd(&bar[XB_TMO], 1u); break; } }
    }
    nloc = mine > 0u ? mine : 1u; nx = cnt > 0u ? cnt : 1u;
}

__device__ __forceinline__ void xcd_barrier(const XcdBarrier& b) {
    asm volatile("s_waitcnt vmcnt(0)" ::: "memory");
    __syncthreads();
    if (threadIdx.x == 0) {
        unsigned* bar = b.bar;
        __builtin_amdgcn_s_waitcnt(0);
        unsigned nloc = b.st[0], nx = b.st[1];
        if (nloc == 0u) { xcd_barrier_complete(bar, b.x, nloc, nx); b.st[0] = nloc; b.st[1] = nx; }
        const unsigned old = xb_add(&bar[XB_XSUB(b.x)], 1u);
        const unsigned gen = old / nloc;
        if (old + 1u == (gen + 1u) * nloc) {
            __builtin_amdgcn_fence(__ATOMIC_RELEASE, "agent");
            asm volatile("s_waitcnt vmcnt(0)" ::: "memory");
            const unsigned og = xb_add(&bar[XB_TOP], 1u);
            const unsigned tg = og / nx;
            if (og + 1u == (tg + 1u) * nx) xb_add(&bar[XB_TOPGEN], 1u);
            else XB_SPIN(xb_ld(&bar[XB_TOPGEN]) == tg, bar);
            __builtin_amdgcn_fence(__ATOMIC_ACQUIRE, "agent");
            xb_add(&bar[XB_XGEN(b.x)], 1u);
            asm volatile("s_waitcnt vmcnt(0)" ::: "memory");
        } else {
            XB_SPIN(xb_ld(&bar[XB_XGEN(b.x)]) == gen, bar);
            __builtin_amdgcn_fence(__ATOMIC_ACQUIRE, "agent");
            asm volatile("s_waitcnt vmcnt(0)" ::: "memory");
        }
    }
    __syncthreads();
}

__device__ __forceinline__ void blk_signal(unsigned* flag) { __threadfence(); __syncthreads(); if (threadIdx.x == 0) __hip_atomic_fetch_add(flag, 1u, __ATOMIC_RELEASE, __HIP_MEMORY_SCOPE_AGENT); }
__device__ __forceinline__ void blk_wait(unsigned* flag, unsigned n) {
    if (threadIdx.x == 0) { while (__hip_atomic_load(flag, __ATOMIC_ACQUIRE, __HIP_MEMORY_SCOPE_AGENT) < n) __builtin_amdgcn_s_sleep(8); }
    __syncthreads(); __threadfence();
}
__global__ void __launch_bounds__(512, 2) mega_fwd(Args a) {
    extern __shared__ __attribute__((aligned(16))) unsigned char lds_raw[];
    LAS unsigned char* lds = (LAS unsigned char*)lds_raw;
    cg::grid_group grid = cg::this_grid();
#define PH_IDS() int tid_l_ = threadIdx.x; asm volatile("" : "+v"(tid_l_)); const int tid = tid_l_, lane = tid & 63, wave = __builtin_amdgcn_readfirstlane(tid >> 6), gw = blockIdx.x * 8 + wave, NGW = gridDim.x * 8; (void)tid; (void)lane; (void)wave; (void)gw; (void)NGW
    { const unsigned long long* ka = (const unsigned long long*)__builtin_amdgcn_kernarg_segment_ptr(); const int tid = threadIdx.x;
      if (tid < 26) *(LAS unsigned long long*)(lds + PTR_OFF + 8 * tid) = ka[tid];
      if (tid < 2) *(LAS unsigned*)(lds + PTR_OFF + 512 + 4 * tid) = 0u; }
    __syncthreads();
    const Ctx c{lds};
#define WSP(T, off) ((T*)(c.ws() + (off)))
    { PH_IDS(); LAS float* scr = (LAS float*)(lds + wave * 16384);
      transpose_w4(c.in(I_W1GU), DM, NGU, WSP(bf16, WS_WGU1), NGU, MapGU(), scr, gw, NGW, lane);
      transpose_w4(c.in(I_W1D), DFF, DM, WSP(bf16, WS_WD1), DM, MapId(), scr, gw, NGW, lane);
      transpose_w4(c.in(I_W2GU), DM, NGU, WSP(bf16, WS_WGU2), NGU, MapGU(), scr, gw, NGW, lane);
      transpose_w4(c.in(I_W2D), DFF, DM, WSP(bf16, WS_WD2), DM, MapId(), scr, gw, NGW, lane);
      transpose_w(c.in(I_WIN), DM, NIN, WSP(bf16, WS_WIN), NINP, MapIn(), scr, gw, NGW, lane);
      transpose_w(c.in(I_WQ), QLORA, NQ, WSP(bf16, WS_WQ), NQ, MapQ(), scr, gw, NGW, lane);
      transpose_w4(c.in(I_WKV), KVLORA, NKV, WSP(bf16, WS_WKV), NKV, MapId(), scr, gw, NGW, lane);
      transpose_w4(c.in(I_WO), DM, DM, WSP(bf16, WS_WO), DM, MapId(), scr, gw, NGW, lane);
      { float* TAB = WSP(float, WS_TAB); for (int e = gw * 64 + lane; e < SEQ * 16; e += NGW * 64) { float cc, ss; rope_cs(e >> 4, e & 15, cc, ss); TAB[2 * e] = cc; TAB[2 * e + 1] = ss; } }
      if (blockIdx.x == 0 && tid < 16) WSP(unsigned, WS_QCTR)[64 * tid] = 0u;
      if (blockIdx.x == 1) { for (int w = tid; w < XCD_BAR_WORDS; w += 512) WSP(unsigned, WS_BAR)[w] = 0u; }
      rp_norm_only(c, c.in(I_G1PRE), WSP(bf16, WS_XN), gw, NGW, lane); }
    grid.sync();
    const XcdBarrier xbar = xcd_barrier_post(WSP(unsigned, WS_BAR), (volatile LAS unsigned*)(lds + PTR_OFF + 512));
#define GSYNC() xcd_barrier(xbar)
#define FLAG(i) (WSP(unsigned, WS_QCTR) + 512 + 64 * (i))
#define SROW(T, off, ld) (WSP(T, off) + (size_t)NP * (ld))
    run_gemm(lds, WSP(bf16, WS_XN), WSP(bf16, WS_WGU1), MPAD, NGU, DM, pg8::EpiSwiGLU{WSP(bf16, WS_ACT), DFF});
    GSYNC();
    run_gemm(lds, WSP(bf16, WS_ACT), WSP(bf16, WS_WD1), NP, DM, DFF, pg8::EpiStore{WSP(bf16, WS_D), DM});
    GSYNC();
    if (blockIdx.x < 4) {
        run_gemm(lds, SROW(bf16, WS_ACT, DFF), WSP(bf16, WS_WD1), 256, DM, DFF, pg8::EpiStore{SROW(bf16, WS_D, DM), DM}); blk_signal(FLAG(1));
        { blk_wait(FLAG(1), 4); PH_IDS(); rp_residual(c, true, false, WSP(bf16, WS_D), 0.5f, c.in(I_G1POST), c.in(I_GMPRE), c.out(), WSP(bf16, WS_XN), NP, NTOK, gw, 4 * 8, lane); }
    } else { PH_IDS(); rp_residual(c, true, false, WSP(bf16, WS_D), 0.5f, c.in(I_G1POST), c.in(I_GMPRE), c.out(), WSP(bf16, WS_XN), 0, NP, gw - 4 * 8, NGW - 4 * 8, lane);
    }
    GSYNC();
    run_gemm(lds, WSP(bf16, WS_XN), WSP(bf16, WS_WIN), NP, NINP, DM, pg8::EpiStore{WSP(bf16, WS_PROJ), NINP});
    GSYNC();
    if (blockIdx.x < 9) {
        run_gemm(lds, SROW(bf16, WS_XN, DM), WSP(bf16, WS_WIN), 256, NINP, DM, pg8::EpiStore{SROW(bf16, WS_PROJ, NINP), NINP});
        blk_signal(FLAG(2));
        { blk_wait(FLAG(2), 9); PH_IDS(); rp_mix(c, NP, NTOK, false, gw, 9 * 8, lane); }
    } else { PH_IDS(); rp_mix(c, 0, NP, true, gw - 9 * 8, NGW - 9 * 8, lane); }
    GSYNC();
    run_gemm(lds, WSP(bf16, WS_CQN), WSP(bf16, WS_WQ), MPAD, NQ, QLORA, pg8::EpiStore{WSP(bf16, WS_QM), NQ});
    run_gemm(lds, WSP(bf16, WS_CKVN), WSP(bf16, WS_WKV), KPAD, NKV, KVLORA, pg8::EpiStore{WSP(bf16, WS_KV), NKV});
    for (int i = blockIdx.x; i < 128; i += gridDim.x) {
        PH_IDS(); const int b = (i >> 3) & 7, h = i & 7;
        if (i < 64) scan_item(c.out() + O_LFP + (size_t)b * SEQ * 8 + h, WSP(float, WS_LK) + (size_t)b * SEQ * 8 + h, SEQ, (LAS float*)lds, tid);
        else scan_item(WSP(float, WS_LFS) + (size_t)b * SKEYS * 8 + h, WSP(float, WS_LK) + ((size_t)NP + (size_t)b * SKEYS) * 8 + h, SKEYS, (LAS float*)lds, tid);
        __syncthreads();
    }
    GSYNC();
    attn_phase(c, lds);
    GSYNC();
    run_gemm(lds, WSP(bf16, WS_XN), WSP(bf16, WS_WO), NP, DM, DM, pg8::EpiStore{WSP(bf16, WS_D), DM});
    GSYNC();
    if (blockIdx.x < 4) {
        run_gemm(lds, SROW(bf16, WS_XN, DM), WSP(bf16, WS_WO), 256, DM, DM, pg8::EpiStore{SROW(bf16, WS_D, DM), DM});
        blk_signal(FLAG(3));
        { blk_wait(FLAG(3), 4); PH_IDS(); rp_residual(c, false, false, WSP(bf16, WS_D), 1.0f, c.in(I_GMPOST), c.in(I_G2PRE), c.out(), WSP(bf16, WS_XN), NP, NTOK, gw, 4 * 8, lane); }
    } else { PH_IDS(); rp_residual(c, false, false, WSP(bf16, WS_D), 1.0f, c.in(I_GMPOST), c.in(I_G2PRE), c.out(), WSP(bf16, WS_XN), 0, NP, gw - 4 * 8, NGW - 4 * 8, lane);
    }
    GSYNC();
    run_gemm(lds, WSP(bf16, WS_XN), WSP(bf16, WS_WGU2), MPAD, NGU, DM, pg8::EpiSwiGLU{WSP(bf16, WS_ACT), DFF});
    GSYNC();
    run_gemm(lds, WSP(bf16, WS_ACT), WSP(bf16, WS_WD2), NP, DM, DFF, pg8::EpiStore{WSP(bf16, WS_D), DM});
    GSYNC();
    if (blockIdx.x < 4) {
        run_gemm(lds, SROW(bf16, WS_ACT, DFF), WSP(bf16, WS_WD2), 256, DM, DFF, pg8::EpiStore{SROW(bf16, WS_D, DM), DM}); blk_signal(FLAG(5));
        { blk_wait(FLAG(5), 4); PH_IDS(); rp_residual(c, false, true, WSP(bf16, WS_D), 0.5f, c.in(I_G2POST), nullptr, c.out(), WSP(bf16, WS_XN), NP, NTOK, gw, 4 * 8, lane); }
    } else { PH_IDS(); rp_residual(c, false, true, WSP(bf16, WS_D), 0.5f, c.in(I_G2POST), nullptr, c.out(), WSP(bf16, WS_XN), 0, NP, gw - 4 * 8, NGW - 4 * 8, lane);
    }
#undef FLAG
#undef SROW
#undef WSP
#undef PH_IDS
#undef GSYNC
}

extern "C" void kernel_launch(void* const* d_in, const int* in_sizes, int n_in, void* d_out, int out_size, void* d_ws, size_t ws_size, hipStream_t stream) {
    static int grid_blocks = 0;
    if (grid_blocks == 0) {
        if (n_in != 24 || (size_t)out_size != O_END || ws_size < WS_END) { fprintf(stderr, "kernel_launch: unexpected shapes: n_in %d out %d ws %zu (need %zu)\n", n_in, out_size, ws_size, (size_t)WS_END); grid_blocks = -1; return; }
        int dev = 0, cus = 0, per_cu = 0;
        hipGetDevice(&dev); hipDeviceGetAttribute(&cus, hipDeviceAttributeMultiprocessorCount, dev);
        if (hipFuncSetAttribute((const void*)mega_fwd, hipFuncAttributeMaxDynamicSharedMemorySize, LDS_BYTES) != hipSuccess) { fprintf(stderr, "kernel_launch: hipFuncSetAttribute failed\n"); grid_blocks = -1; return; }
        if (hipOccupancyMaxActiveBlocksPerMultiprocessor(&per_cu, (const void*)mega_fwd, 512, LDS_BYTES) != hipSuccess || per_cu < 1) { fprintf(stderr, "kernel_launch: occupancy query says %d\n", per_cu); per_cu = 1; (void)hipGetLastError(); }
        grid_blocks = cus * per_cu;
    }
    if (grid_blocks < 0) return;
    Args a{};
    for (int i = 0; i < 24; ++i) a.in[i] = (const float*)d_in[i];
    a.out = (float*)d_out; a.ws = (unsigned char*)d_ws;
    void* args[] = {&a};
    hipError_t e = hipLaunchCooperativeKernel((const void*)mega_fwd, dim3(grid_blocks), dim3(512), args, LDS_BYTES, stream);
    if (e != hipSuccess) fprintf(stderr, "cooperative launch failed: %s (grid %d)\n", hipGetErrorString(e), grid_blocks);
}
```
